# Optimizing an MI355X kernel written in HIP

```python
import math
import jax, jax.numpy as jnp
from jax import lax
import numpy as np

D_MODEL = 2048
BATCH = 2
SEQ = 4096
DEPTH = 1

D_MIX = D_MODEL
EPS = 1e-6
M_WIDTH = D_MIX // 2
M_HEADS = 4
M_HD = M_WIDTH // M_HEADS
M_CHUNK = 64
CONV_K = 4
N_WIDTH = D_MIX - M_WIDTH
N_HEADS = 16
N_HD = N_WIDTH // N_HEADS
N_KV = 4
N_HPG = N_HEADS // N_KV
KV_W = N_KV * N_HD
CMP_LEN = 32
CMP_STRIDE = 16
CMP_HIDDEN = 2 * N_HD
SLC_LEN = 64
SLC_TOPN = 16
WIN = 512
QBLK = 128

IN_SPLITS = (M_WIDTH, M_WIDTH, M_WIDTH, M_WIDTH, M_HEADS, M_HEADS,
             N_WIDTH, KV_W, KV_W, KV_W, KV_W, KV_W, KV_W, 3 * N_HEADS, N_WIDTH)
D_IN = sum(IN_SPLITS)

kernel_name = "hymba_mlstm_nsa_adaln_layer"


def rmsnorm(x, g):
    x = x.astype(jnp.float32)
    return x * lax.rsqrt(jnp.mean(x * x, axis=-1, keepdims=True) + EPS) * g


def masked_softmax(s, mask, axis):
    s = jnp.where(mask, s.astype(jnp.float32), -jnp.inf)
    m = jnp.max(s, axis=axis, keepdims=True)
    m = jnp.where(jnp.isfinite(m), m, 0.0)
    e = jnp.where(mask, jnp.exp(s - m), 0.0)
    z = jnp.sum(e, axis=axis, keepdims=True)
    return e / jnp.where(z > 0, z, 1.0)


def alibi_slopes():
    return np.array([2.0 ** (-8.0 * (h + 1) / N_HEADS) for h in range(N_HEADS)], np.float32)


def mlstm_chunkwise(q, k, v, i_pre, f_pre):
    B, H, T, D = q.shape
    L = M_CHUNK
    nch = T // L
    k = k * (D ** -0.5)
    logf = jax.nn.log_sigmoid(f_pre)
    to_c = lambda a: jnp.moveaxis(a.reshape(a.shape[:2] + (nch, L) + a.shape[3:]), 2, 0)
    xs = (to_c(q), to_c(k), to_c(v), to_c(i_pre), to_c(logf))
    causal = jnp.tril(jnp.ones((L, L), bool))

    def step(carry, inp):
        C, n, m = carry
        qb, kb, vb, ib, fb = inp
        b = jnp.cumsum(fb, axis=-1)
        Dm = jnp.where(causal, b[..., :, None] - b[..., None, :] + ib[..., None, :], -jnp.inf)
        inter = b + m[..., None]
        m_t = jnp.maximum(inter, jnp.max(Dm, axis=-1))
        w_in = jnp.exp(Dm - m_t[..., None])
        w_st = jnp.exp(inter - m_t)
        s = jnp.einsum('bhld,bhsd->bhls', qb, kb) * w_in
        num = w_st[..., None] * jnp.einsum('bhld,bhde->bhle', qb, C) + jnp.einsum('bhls,bhse->bhle', s, vb)
        den = w_st * jnp.einsum('bhld,bhd->bhl', qb, n) + jnp.sum(s, axis=-1)
        h = num / jnp.maximum(jnp.abs(den), jnp.exp(-m_t))[..., None]
        bL = b[..., -1]
        w_end = bL[..., None] - b + ib
        m_new = jnp.maximum(bL + m, jnp.max(w_end, axis=-1))
        decay = jnp.exp(bL + m - m_new)
        wk = jnp.exp(w_end - m_new[..., None])
        C_new = decay[..., None, None] * C + jnp.einsum('bhs,bhsd,bhse->bhde', wk, kb, vb)
        n_new = decay[..., None] * n + jnp.einsum('bhs,bhsd->bhd', wk, kb)
        return (C_new, n_new, m_new), h

    init = (jnp.zeros((B, H, D, D), jnp.float32), jnp.zeros((B, H, D), jnp.float32),
            jnp.zeros((B, H), jnp.float32))
    _, hs = lax.scan(step, init, xs)
    return jnp.moveaxis(hs, 0, 2).reshape(B, H, T, D)


def mlstm_group(xm, vm, om, zm, im, fm, conv_w, conv_b, wq, wk, norm_w, skip, f_bias):
    B, T, _ = xm.shape
    xpad = jnp.pad(xm, ((0, 0), (CONV_K - 1, 0), (0, 0)))
    xc = conv_b + xpad[:, 0:T] * conv_w[0]
    for j in range(1, CONV_K):
        xc = xc + xpad[:, j:j + T] * conv_w[j]
    xc = jax.nn.silu(xc)
    xch = xc.reshape(B, T, M_HEADS, M_HD)
    q = jnp.einsum('bthd,hde->bhte', xch, wq)
    k = jnp.einsum('bthd,hde->bhte', xch, wk)
    v = vm.reshape(B, T, M_HEADS, M_HD).transpose(0, 2, 1, 3)
    h = mlstm_chunkwise(q, k, v, im.transpose(0, 2, 1), (fm + f_bias).transpose(0, 2, 1))
    h = h.transpose(0, 2, 1, 3)
    mu = jnp.mean(h, axis=-1, keepdims=True)
    var = jnp.mean(jnp.square(h - mu), axis=-1, keepdims=True)
    hn = ((h - mu) * lax.rsqrt(var + EPS)).reshape(B, T, M_WIDTH) * norm_w
    out = jax.nn.sigmoid(om) * hn + skip * xc
    return out * jax.nn.silu(zm)


def nsa_group(qn, kc, vc, ks, vs, kw, vw, gl, zn, pos_k, pos_v, w1_k, w2_k, w1_v, w2_v):
    B, T, _ = qn.shape
    G, HPG, dh = N_KV, N_HPG, N_HD
    n_cmp = (T - CMP_LEN) // CMP_STRIDE + 1
    n_slc = T // SLC_LEN
    n_top = min(SLC_TOPN, n_slc)
    n_qb = T // QBLK
    q = qn.reshape(B, T, G, HPG, dh) * (dh ** -0.5)
    kc = kc.reshape(B, T, G, dh); vc = vc.reshape(B, T, G, dh)
    ks = ks.reshape(B, T, G, dh); vs = vs.reshape(B, T, G, dh)
    kw = kw.reshape(B, T, G, dh); vw = vw.reshape(B, T, G, dh)

    cidx = np.arange(n_cmp)[:, None] * CMP_STRIDE + np.arange(CMP_LEN)[None, :]

    def compress(a, pos, w1, w2):
        blk = a[:, cidx] + pos[None, None, :, None, :]
        blk = blk.transpose(0, 1, 3, 2, 4).reshape(B, n_cmp, G, CMP_LEN * dh)
        return jax.nn.gelu(blk @ w1) @ w2

    k_cmp = compress(kc, pos_k, w1_k, w2_k)
    v_cmp = compress(vc, pos_v, w1_v, w2_v)
    cmp_end = jnp.asarray(cidx[:, -1], jnp.int32)
    cmp_mid = jnp.asarray(cidx.mean(-1), jnp.float32)
    s_start = np.arange(n_slc) * SLC_LEN
    overlap = jnp.asarray((cidx[:, 0][:, None] <= s_start[None, :] + SLC_LEN - 1)
                          & (cidx[:, -1][:, None] >= s_start[None, :]), jnp.float32)
    slopes = jnp.asarray(alibi_slopes()).reshape(G, HPG)

    ks_blk = ks.reshape(B, n_slc, SLC_LEN, G, dh).transpose(0, 3, 1, 2, 4)
    vs_blk = vs.reshape(B, n_slc, SLC_LEN, G, dh).transpose(0, 3, 1, 2, 4)
    kw_pad = jnp.pad(kw, ((0, 0), (WIN, 0), (0, 0), (0, 0)))
    vw_pad = jnp.pad(vw, ((0, 0), (WIN, 0), (0, 0), (0, 0)))
    gates = jax.nn.sigmoid(gl).reshape(B, T, G, HPG, 3)
    q_blocks = q.reshape(B, n_qb, QBLK, G, HPG, dh).swapaxes(0, 1)
    g_blocks = gates.reshape(B, n_qb, QBLK, G, HPG, 3).swapaxes(0, 1)
    starts = jnp.arange(n_qb, dtype=jnp.int32) * QBLK
    bi = jnp.arange(B)[:, None, None, None]
    gi = jnp.arange(G)[None, :, None, None]
    sidx = jnp.arange(n_slc, dtype=jnp.int32)

    def block(args):
        qb, gb, start = args
        t = start + jnp.arange(QBLK, dtype=jnp.int32)
        tf = t.astype(jnp.float32)
        s_c = jnp.einsum('bqghd,bjgd->bqghj', qb, k_cmp)
        s_c = s_c - slopes[None, None, :, :, None] * (tf[:, None] - cmp_mid[None, :])[None, :, None, None, :]
        mask_c = (cmp_end[None, :] <= t[:, None])[None, :, None, None, :]
        p_c = masked_softmax(s_c, mask_c, -1)
        o_c = jnp.einsum('bqghj,bjgd->bqghd', p_c, v_cmp)
        imp = jnp.einsum('bqghj,js->bgqs', p_c, overlap)
        cur = t // SLC_LEN
        imp = jnp.where(sidx[None, :] <= cur[:, None], imp, -jnp.inf)
        imp = jnp.where((sidx[None, :] == 0) | (sidx[None, :] == cur[:, None]), jnp.inf, imp)
        top_val, top_idx = lax.top_k(imp, n_top)
        sel_ok = top_val > -jnp.inf
        k_sel = ks_blk[bi, gi, top_idx]
        v_sel = vs_blk[bi, gi, top_idx]
        qg = qb.transpose(0, 2, 1, 3, 4)
        s_s = jnp.einsum('bgqhd,bgqnld->bgqhnl', qg, k_sel)
        pos = top_idx[..., None] * SLC_LEN + jnp.arange(SLC_LEN, dtype=jnp.int32)
        dist_s = (t[None, None, :, None, None] - pos).astype(jnp.float32)
        s_s = s_s - slopes[None, :, None, :, None, None] * dist_s[:, :, :, None]
        mask_s = ((pos <= t[None, None, :, None, None]) & sel_ok[..., None])[:, :, :, None]
        p_s = masked_softmax(s_s, mask_s, (-2, -1))
        o_s = jnp.einsum('bgqhnl,bgqnld->bgqhd', p_s, v_sel).transpose(0, 2, 1, 3, 4)
        k_win = lax.dynamic_slice_in_dim(kw_pad, start, QBLK + WIN, axis=1)
        v_win = lax.dynamic_slice_in_dim(vw_pad, start, QBLK + WIN, axis=1)
        pos_w = start - WIN + jnp.arange(QBLK + WIN, dtype=jnp.int32)
        dw = t[:, None] - pos_w[None, :]
        mask_w = ((dw >= 0) & (dw < WIN) & (pos_w[None, :] >= 0))[None, :, None, None, :]
        s_w = jnp.einsum('bqghd,bkgd->bqghk', qb, k_win)
        s_w = s_w - slopes[None, None, :, :, None] * dw.astype(jnp.float32)[None, :, None, None, :]
        p_w = masked_softmax(s_w, mask_w, -1)
        o_w = jnp.einsum('bqghk,bkgd->bqghd', p_w, v_win)
        return gb[..., 0:1] * o_c + gb[..., 1:2] * o_s + gb[..., 2:3] * o_w

    o = lax.map(block, (q_blocks, g_blocks, starts))
    o = o.swapaxes(0, 1).reshape(B, T, N_WIDTH)
    return o * jax.nn.silu(zn)


def setup_inputs(seed: int = 0) -> dict:
    key = jax.random.key(seed)
    k = jax.random.split(key, 24)
    f32 = jnp.float32
    nrm = lambda kk, shape, scale: jax.random.normal(kk, shape, f32) * scale
    L = DEPTH
    return {
        'x': nrm(k[0], (BATCH, SEQ, D_MODEL), 1.0),
        'c': nrm(k[1], (BATCH, D_MODEL), 1.0),
        'ln_g': 1.0 + nrm(k[2], (L, D_MODEL), 0.02),
        'w_ada': nrm(k[3], (L, D_MODEL, 3 * D_MODEL), 0.5 * D_MODEL ** -0.5),
        'b_ada': nrm(k[4], (L, 3 * D_MODEL), 0.02),
        'w_in': nrm(k[5], (L, D_MODEL, D_IN), D_MODEL ** -0.5),
        'b_in': nrm(k[6], (L, D_IN), 0.02),
        'm_conv_w': nrm(k[7], (L, CONV_K, M_WIDTH), CONV_K ** -0.5),
        'm_conv_b': nrm(k[8], (L, M_WIDTH), 0.02),
        'm_wq': nrm(k[9], (L, M_HEADS, M_HD, M_HD), M_HD ** -0.5),
        'm_wk': nrm(k[10], (L, M_HEADS, M_HD, M_HD), M_HD ** -0.5),
        'm_norm_w': 1.0 + nrm(k[11], (L, M_WIDTH), 0.02),
        'm_skip': 1.0 + nrm(k[12], (L, M_WIDTH), 0.02),
        'm_f_bias': jnp.linspace(3.0, 6.0, M_HEADS, dtype=f32)[None, :] + nrm(k[13], (L, M_HEADS), 0.02),
        'n_pos_k': nrm(k[14], (L, CMP_LEN, N_HD), 0.5),
        'n_pos_v': nrm(k[15], (L, CMP_LEN, N_HD), 0.5),
        'n_w1_k': nrm(k[16], (L, CMP_LEN * N_HD, CMP_HIDDEN), (CMP_LEN * N_HD) ** -0.5),
        'n_w2_k': nrm(k[17], (L, CMP_HIDDEN, N_HD), CMP_HIDDEN ** -0.5),
        'n_w1_v': nrm(k[18], (L, CMP_LEN * N_HD, CMP_HIDDEN), (CMP_LEN * N_HD) ** -0.5),
        'n_w2_v': nrm(k[19], (L, CMP_HIDDEN, N_HD), CMP_HIDDEN ** -0.5),
        'w_out': nrm(k[20], (L, D_MIX, D_MODEL), D_MIX ** -0.5),
        'final_g': 1.0 + nrm(k[21], (D_MODEL,), 0.02),
    }


def reference(x, c, ln_g, w_ada, b_ada, w_in, b_in, m_conv_w, m_conv_b, m_wq, m_wk, m_norm_w,
              m_skip, m_f_bias, n_pos_k, n_pos_v, n_w1_k, n_w2_k, n_w1_v, n_w2_v, w_out, final_g):
    out_dtype = x.dtype
    h_res = x.astype(jnp.float32)
    cf = c.astype(jnp.float32)
    offsets = [int(o) for o in np.cumsum(IN_SPLITS)[:-1]]
    for l in range(DEPTH):
        mod = jax.nn.silu(cf) @ w_ada[l] + b_ada[l]
        shift, scale, gate = jnp.split(mod, 3, axis=-1)
        h = rmsnorm(h_res, ln_g[l]) * (1.0 + scale[:, None]) + shift[:, None]
        p = h @ w_in[l] + b_in[l]
        (m_x, m_v, m_o, m_z, m_i, m_f, n_q, n_kc, n_vc, n_ks, n_vs, n_kw, n_vw, n_g, n_z) = \
            jnp.split(p, offsets, axis=-1)
        y_m = mlstm_group(m_x, m_v, m_o, m_z, m_i, m_f, m_conv_w[l], m_conv_b[l], m_wq[l], m_wk[l],
                          m_norm_w[l], m_skip[l], m_f_bias[l])
        y_n = nsa_group(n_q, n_kc, n_vc, n_ks, n_vs, n_kw, n_vw, n_g, n_z, n_pos_k[l], n_pos_v[l],
                        n_w1_k[l], n_w2_k[l], n_w1_v[l], n_w2_v[l])
        y = jnp.concatenate([y_m, y_n], axis=-1) @ w_out[l]
        h_res = h_res + gate[:, None] * y
    return rmsnorm(h_res, final_g).astype(out_dtype)
```

```cpp
#include <hip/hip_runtime.h>
#include <cstdint>
#include <cstdio>

#define GAS __attribute__((address_space(1)))
#define LAS __attribute__((address_space(3)))
typedef unsigned short bf16_t;
typedef float f32x4 __attribute__((ext_vector_type(4)));
typedef float f32x2 __attribute__((ext_vector_type(2)));
typedef unsigned u32x4 __attribute__((ext_vector_type(4)));
typedef unsigned u32x2 __attribute__((ext_vector_type(2)));
typedef short bf16x8 __attribute__((ext_vector_type(8)));

constexpr int NB = 2, T = 4096, DM = 2048, MR = NB * T;
constexpr int DIN = 7736, NPAD = 7936, PW = 7680;
constexpr int MW = 1024, MH = 4, MHD = 256;
constexpr int NHEADS = 16, NHD = 64, NG = 4, HPG = 4;
constexpr int NCMP = 255, NSLC = 64, TOPN = 16, WIN = 512;
constexpr int LC = 256, NCH = T / LC;
constexpr int PC_MX = 0, PC_MV = 1024, PC_MO = 2048, PC_MZ = 3072, PC_NQ = 4096, PC_KC = 5120, PC_VC = 5376, PC_KS = 5632, PC_VS = 5888, PC_KW = 6144, PC_VW = 6400, PC_NZ = 6656;
constexpr float EPS = 1e-6f;

constexpr size_t MiB = 1u << 20;
constexpr size_t WS_CTL = 0, CTL_ZERO_BYTES = 1 * MiB;
constexpr size_t WS_SMALL = 1 * MiB;
constexpr size_t SM_BIASP = WS_SMALL + 0 * 65536, SM_MOD = WS_SMALL + 1 * 65536, SM_C1 = WS_SMALL + 2 * 65536, SM_W2T = WS_SMALL + 3 * 65536,
                 SM_NU = WS_SMALL + 4 * 65536  , SM_DEN = WS_SMALL + 8 * 65536  ;
constexpr size_t WS_WQK = 2 * MiB, WS_W1T = 3 * MiB, WS_GF = 4 * MiB, WS_GATE = 6 * MiB, WS_CMP = 7 * MiB, WS_WOUT = 8 * MiB, WS_WIN = 16 * MiB, WS_HB = 48 * MiB;
constexpr size_t WS_XC = 16 * MiB, WS_Q = 32 * MiB, WS_K = 48 * MiB, WS_KT = 64 * MiB, WS_Y = 32 * MiB;
constexpr size_t WS_P = 80 * MiB, WS_VST = 200 * MiB, WS_BT2 = 216 * MiB, WS_NVS = 248 * MiB, WS_NVW = 252 * MiB, WS_END = 256 * MiB;
constexpr size_t OUT_A2 = 0, OUT_UT = 32 * MiB;
static_assert(WS_P + (size_t)MR * PW * 2 <= WS_VST && WS_WIN + (size_t)NPAD * DM * 2 <= WS_HB && WS_KT + 16 * MiB <= WS_P, "ws map");

__device__ __forceinline__ float bf2f(bf16_t b) { return __uint_as_float((unsigned)b << 16); }
__device__ __forceinline__ unsigned f2bf(float f) { unsigned u = __float_as_uint(f); return (u + 0x7fffu + ((u >> 16) & 1u)) >> 16; }
__device__ __forceinline__ unsigned pk2(float lo, float hi) { return f2bf(lo) | (f2bf(hi) << 16); }
__device__ __forceinline__ float wave_sum(float v) {
#pragma unroll
    for (int o = 1; o < 64; o <<= 1) v += __shfl_xor(v, o);
    return v;
}
__device__ __forceinline__ float wave_max(float v) {
#pragma unroll
    for (int o = 1; o < 64; o <<= 1) v = fmaxf(v, __shfl_xor(v, o));
    return v;
}
__device__ __forceinline__ float sigmoidf_(float x) { return 1.0f / (1.0f + __expf(-x)); }
__device__ __forceinline__ float siluf_(float x) { return x / (1.0f + __expf(-x)); }
__device__ __forceinline__ float gelu_tanh(float x) { const float u = 0.7978845608028654f * (x + 0.044715f * x * x * x); const float e = __expf(2.0f * u); return 0.5f * x * (1.0f + (1.0f - 2.0f / (e + 1.0f))); }
__device__ __forceinline__ float logsigmoidf_(float x) { return fminf(x, 0.0f) - log1pf(__expf(-fabsf(x))); }
__host__ __device__ __forceinline__ int orig_col(int c) {
    if (c < 4096) return c;
    if (c < 6656) return c + 8;
    if (c < 7680) return c + 56;
    if (c < 7688) return c - 3584;
    if (c < 7736) return c - 1024;
    return -1;
}

struct Args { const float* in[22]; float* out; unsigned char* ws; int ph_lo, ph_hi, li, pad; };
enum { I_X = 0, I_C, I_LNG, I_WADA, I_BADA, I_WIN, I_BIN, I_CONVW, I_CONVB, I_WQ, I_WK, I_NORMW, I_SKIP, I_FBIAS, I_POSK, I_POSV, I_W1K, I_W2K, I_W1V, I_W2V, I_WOUT, I_FINALG };

struct Frame {
    LAS unsigned char* lds;
    int tid, lane, wave, G, bid;
    const float* in[22]; float* out; unsigned char* ws;
};
constexpr int NWAVES = 8, NTHREADS = 512;
constexpr int LDS_BYTES = 147456;

struct Unit { int pm, pn; };
struct SchedGrid {
    const bf16_t* A; const bf16_t* Bt; int lda, ldb, K, nM, nN, G, c;
    __device__ bool next(int i, Unit& u) const { const long L = (long)i * G + c; if (L >= (long)nM * nN) return false; u.pm = (int)(L % nM); u.pn = (int)(L / nM); return true; }
    __device__ void ptrs(const Unit& u, const bf16_t*& a, const bf16_t*& b) const { a = A + (size_t)u.pm * 256 * lda; b = Bt + (size_t)u.pn * 256 * ldb; }
};

struct EpiInproj {
    bf16_t* P; float* GF; const float* biasP;
    __device__ __forceinline__ void store4(const Unit& u, int r, int c, f32x4 v) const {
        const int row = u.pm * 256 + r, col = u.pn * 256 + c;
        const f32x4 b = *(const f32x4*)(biasP + col); v = v + b;
        if (u.pn < 30) { u32x2 w; w.x = pk2(v[0], v[1]); w.y = pk2(v[2], v[3]); *(u32x2*)(P + (size_t)row * PW + col) = w; }
        else if (c < 64) { *(f32x4*)(GF + (size_t)row * 64 + c) = v; }
    }
};
struct EpiQ {
    bf16_t* Q; bf16_t* A2; const float* AArr;
    __device__ __forceinline__ void store4(const Unit& u, int r, int c, f32x4 v) const {
        const int row = u.pm * 256 + r, h = u.pn, b = row >> 12, t = row & 4095, bh = b * 4 + h;
        u32x2 w; w.x = pk2(v[0], v[1]); w.y = pk2(v[2], v[3]); *(u32x2*)(Q + (size_t)row * 1024 + h * 256 + c) = w;
        const int t0 = t & ~(LC - 1); const float Aprev = t0 ? AArr[bh * T + t0 - 1] : 0.0f; const float ws = __expf(Aprev - AArr[bh * T + t]);
        v = v * ws; w.x = pk2(v[0], v[1]); w.y = pk2(v[2], v[3]); *(u32x2*)(A2 + (size_t)row * 2048 + h * 512 + 256 + c) = w;
    }
};
struct EpiK {
    bf16_t* Kn;
    __device__ __forceinline__ void store4(const Unit& u, int r, int c, f32x4 v) const {
        const int row = u.pm * 256 + r, h = u.pn;
        u32x2 w; w.x = pk2(v[0], v[1]); w.y = pk2(v[2], v[3]); *(u32x2*)(Kn + (size_t)row * 1024 + h * 256 + c) = w;
    }
};
struct EpiKT {
    bf16_t* KT;
    __device__ __forceinline__ void store4(const Unit& u, int r, int c, f32x4 v) const {
        const int tok = u.pn * 256 + c, b = tok >> 12, t = tok & 4095, bh = b * 4 + u.pm;
        u32x2 w; w.x = pk2(v[0], v[1]); w.y = pk2(v[2], v[3]); *(u32x2*)(KT + ((size_t)bh * 256 + r) * T + t) = w;
    }
};
struct EpiS {
    bf16_t* A2; const float* aArr; const float* AArr;
    __device__ __forceinline__ void store4(const Unit& u, int r, int c, f32x4 v) const {
        const int bh = u.pm >> 4, ch = u.pm & 15, b = bh >> 2, h = bh & 3, t = ch * LC + r, row = b * T + t;
        const float At = AArr[bh * T + t]; const f32x4 as = *(const f32x4*)(aArr + bh * T + ch * LC + c);
#pragma unroll
        for (int i = 0; i < 4; ++i) v[i] = (c + i <= r) ? v[i] * __expf(as[i] - At) : 0.0f;
        u32x2 w; w.x = pk2(v[0], v[1]); w.y = pk2(v[2], v[3]); *(u32x2*)(A2 + (size_t)row * 2048 + h * 512 + c) = w;
    }
};
struct EpiUT {
    float* UT;
    __device__ __forceinline__ void store4(const Unit& u, int r, int c, f32x4 v) const { *(f32x4*)(UT + ((size_t)u.pm * 256 + r) * 256 + c) = v; }
};
struct EpiNum {
    float* H; const float* den; const float* AArr; const float* BArr;
    __device__ __forceinline__ void store4(const Unit& u, int r, int c, f32x4 v) const {
        const int bh = u.pm >> 4, ch = u.pm & 15, b = bh >> 2, h = bh & 3, t = ch * LC + r, row = b * T + t;
        const float d = fmaxf(fabsf(den[bh * T + t]), __expf(-(BArr[bh * T + t] + AArr[bh * T + t])));
        *(f32x4*)(H + (size_t)row * 1024 + h * 256 + c) = v * (1.0f / d);
    }
};
struct EpiOut {
    const float* x; const float* mod; float* out;
    __device__ __forceinline__ void store4(const Unit& u, int r, int c, f32x4 v) const {
        const int row = u.pm * 256 + r, col = u.pn * 256 + c, b = row >> 12;
        const f32x4 g = *(const f32x4*)(mod + b * 6144 + 4096 + col); const f32x4 xv = *(const f32x4*)(x + (size_t)row * DM + col);
        *(f32x4*)(out + (size_t)row * DM + col) = xv + g * v;
    }
};
struct SchedQK {
    const bf16_t* XC; const bf16_t* W; int sel, G, c; int lda, ldb, K;
    __device__ bool next(int i, Unit& u) const { const int L = i * G + c; if (L >= 128) return false; u.pm = L & 31; u.pn = L >> 5; return true; }
    __device__ void ptrs(const Unit& u, const bf16_t*& a, const bf16_t*& b) const { a = XC + (size_t)u.pm * 256 * 1024 + u.pn * 256; b = W + ((size_t)u.pn * 512 + sel * 256) * 256; }
};
struct SchedKT {
    const bf16_t* XC; const bf16_t* W; int G, c; int lda, ldb, K;
    __device__ bool next(int i, Unit& u) const { const int L = i * G + c; if (L >= 128) return false; u.pm = L >> 5; u.pn = L & 31; return true; }
    __device__ void ptrs(const Unit& u, const bf16_t*& a, const bf16_t*& b) const { a = W + ((size_t)u.pm * 512 + 256) * 256; b = XC + (size_t)u.pn * 256 * 1024 + u.pm * 256; }
};
struct SchedChunk {
    const bf16_t* A; const bf16_t* Bt; int G, c; int lda, ldb, K; int mode;
    __device__ bool next(int i, Unit& u) const { const int L = i * G + c; if (L >= 128) return false; u.pm = L; u.pn = 0; return true; }
    __device__ void ptrs(const Unit& u, const bf16_t*& a, const bf16_t*& b) const {
        const int bh = u.pm >> 4, ch = u.pm & 15, bb = bh >> 2, h = bh & 3;
        if (mode == 0) { a = A + ((size_t)bb * T + ch * LC) * 1024 + h * 256; b = Bt + ((size_t)bb * T + ch * LC) * 1024 + h * 256; }
        else if (mode == 1) { a = A + (size_t)bh * 256 * T + ch * LC; b = Bt + (size_t)bh * 256 * T + ch * LC; }
        else { a = A + ((size_t)bb * T + ch * LC) * 2048 + h * 512; b = Bt + (size_t)u.pm * 256 * 512; }
    }
};

template <class Sched, class Epi>
__device__ __forceinline__ void naive_gemm(Frame& F, const Sched& S, const Epi& E) {
    LAS float* As = (LAS float*)F.lds;
    LAS float* Bs = As + 128 * 33;
    const int tid = F.tid, tr = tid >> 4, tc = tid & 15;
    Unit u;
    for (int i = 0; S.next(i, u); ++i) {
        const bf16_t *Ab, *Bb; S.ptrs(u, Ab, Bb);
        for (int sm = 0; sm < 2; ++sm)
            for (int sn = 0; sn < 4; ++sn) {
                float acc[4][4];
#pragma unroll
                for (int a = 0; a < 4; ++a)
#pragma unroll
                    for (int b = 0; b < 4; ++b) acc[a][b] = 0.f;
                for (int k0 = 0; k0 < S.K; k0 += 32) {
                    __syncthreads();
                    for (int e = tid; e < 128 * 32; e += NTHREADS) { const int r = e >> 5, k = e & 31; As[r * 33 + k] = bf2f(Ab[(size_t)(sm * 128 + r) * S.lda + k0 + k]); }
                    for (int e = tid; e < 64 * 32; e += NTHREADS) { const int r = e >> 5, k = e & 31; Bs[r * 33 + k] = bf2f(Bb[(size_t)(sn * 64 + r) * S.ldb + k0 + k]); }
                    __syncthreads();
#pragma unroll 8
                    for (int k = 0; k < 32; ++k) {
                        float av[4], bv[4];
#pragma unroll
                        for (int a = 0; a < 4; ++a) av[a] = As[(tr * 4 + a) * 33 + k];
#pragma unroll
                        for (int b = 0; b < 4; ++b) bv[b] = Bs[(tc * 4 + b) * 33 + k];
#pragma unroll
                        for (int a = 0; a < 4; ++a)
#pragma unroll
                            for (int b = 0; b < 4; ++b) acc[a][b] += av[a] * bv[b];
                    }
                }
#pragma unroll
                for (int a = 0; a < 4; ++a) E.store4(u, sm * 128 + tr * 4 + a, sn * 64 + tc * 4, (f32x4){acc[a][0], acc[a][1], acc[a][2], acc[a][3]});
            }
    }
    __syncthreads();
}

namespace pg8 {
constexpr int BM = 256, BK = 64, HALF = 128, HTB = HALF * BK * 2, STAGE_BYTES = 8 * HTB;
__host__ __device__ __forceinline__ int lds_byte(int r, int c) { const int st = (r >> 4) * 2 + (c >> 5), rr = r & 15, cc = c & 31, ob = rr * 64 + cc * 2; return st * 1024 + (ob ^ (((ob >> 9) & 1) << 5)); }
__host__ __device__ __forceinline__ void stage_rc(int b, int& R, int& C) { const int st = b / 1024, sb = b % 1024, swz = sb ^ (((sb >> 9) & 1) << 5); R = (st >> 1) * 16 + swz / 64; C = (st & 1) * 32 + (swz % 64) / 2; }

template <class Sched, class Epi>
__device__ __forceinline__ void gemm_phase(LAS unsigned char* lds, const Sched& S, const Epi& E) {
    const int tid = threadIdx.x, wid = __builtin_amdgcn_readfirstlane(tid >> 6), lane = tid & 63, wr = wid >> 2, wc = wid & 3, fr = lane & 15, fq = lane >> 4;
    const int nt = S.K / BK;
    unsigned voffA[2], voffB[2];
#pragma unroll
    for (int i = 0; i < 2; ++i) { int R, C; stage_rc(tid * 16 + i * 8192, R, C); voffA[i] = (unsigned)(R * S.lda + C) * 2u; voffB[i] = (unsigned)(R * S.ldb + C) * 2u; }
    const size_t kstep = (size_t)(BK * 2);
    const size_t hstepA = (size_t)HALF * S.lda * 2, hstepB = (size_t)HALF * S.ldb * 2;
    const unsigned ldsw = (unsigned)wid * 1024u;
    const int aoff = lds_byte(wr * 64 + fr, fq * 8), boff = lds_byte(wc * 32 + fr, fq * 8);
#define PG8_SA(b, h) (((b) * 2 + (h)) * HTB)
#define PG8_SB(b, h) ((4 + (b) * 2 + (h)) * HTB)
#define PG8_STAGE(bufoff, gbase, voff) do { _Pragma("unroll") for (int _i = 0; _i < 2; ++_i) \
        __builtin_amdgcn_global_load_lds((const unsigned*)((const char*)(gbase) + (voff)[_i]), (LAS unsigned*)(lds + (bufoff) + ldsw + _i * 8192), 16, 0, 0); } while (0)
#define PG8_LDA(dst, b, h) do { _Pragma("unroll") for (int m = 0; m < 4; ++m) _Pragma("unroll") for (int k = 0; k < 2; ++k) dst[m][k] = *(const LAS bf16x8*)(lds + PG8_SA(b, h) + aoff + m * 2048 + k * 1024); } while (0)
#define PG8_LDB(dst, b, h) do { _Pragma("unroll") for (int n = 0; n < 2; ++n) _Pragma("unroll") for (int k = 0; k < 2; ++k) dst[n][k] = *(const LAS bf16x8*)(lds + PG8_SB(b, h) + boff + n * 2048 + k * 1024); } while (0)
#define PG8_MMA(ai, bj, At, Bt) do { __builtin_amdgcn_s_setprio(1); _Pragma("unroll") for (int m = 0; m < 4; ++m) _Pragma("unroll") for (int n = 0; n < 2; ++n) _Pragma("unroll") for (int k = 0; k < 2; ++k) \
        acc[ai][bj][m][n] = __builtin_amdgcn_mfma_f32_16x16x32_bf16(Bt[n][k], At[m][k], acc[ai][bj][m][n], 0, 0, 0); __builtin_amdgcn_s_setprio(0); } while (0)
#define PG8_WAIT_V(n) asm volatile("s_waitcnt vmcnt(" #n ")" ::: "memory")
#define PG8_WAIT_L(n) asm volatile("s_waitcnt lgkmcnt(" #n ")" ::: "memory")
#define PG8_BAR __builtin_amdgcn_s_barrier()
#define PG8_SCHED __builtin_amdgcn_sched_barrier(0)
    Unit cur, nxt; int ui = 0;
    if (!S.next(0, cur)) return;
    f32x4 acc[2][2][4][2];
#pragma unroll
    for (int a = 0; a < 2; ++a)
#pragma unroll
        for (int b = 0; b < 2; ++b)
#pragma unroll
            for (int m = 0; m < 4; ++m)
#pragma unroll
                for (int n = 0; n < 2; ++n) acc[a][b][m][n] = (f32x4){0.f, 0.f, 0.f, 0.f};
    bf16x8 At[4][2], B0[2][2], B1[2][2];
    const bf16_t *pa, *pb; S.ptrs(cur, pa, pb);
    const char* cA = (const char*)pa; const char* cB = (const char*)pb;
    PG8_STAGE(PG8_SB(0, 0), cB, voffB); PG8_STAGE(PG8_SB(0, 1), cB + hstepB, voffB); PG8_STAGE(PG8_SA(0, 0), cA, voffA); PG8_STAGE(PG8_SA(0, 1), cA + hstepA, voffA);
    if (wr == 1) PG8_BAR;
    PG8_WAIT_V(2); PG8_BAR;
    PG8_STAGE(PG8_SB(1, 0), cB + kstep, voffB); PG8_STAGE(PG8_SA(1, 0), cA + kstep, voffA); PG8_STAGE(PG8_SB(1, 1), cB + hstepB + kstep, voffB);
    PG8_WAIT_V(6); PG8_BAR;
    for (;;) {
        const bool has_next = S.next(ui + 1, nxt);
        const char* nA = cA; const char* nB = cB;
        if (has_next) { const bf16_t *qa, *qb; S.ptrs(nxt, qa, qb); nA = (const char*)qa; nB = (const char*)qb; }
        for (int t = 0; t < nt; t += 2) {
            const bool last = (t == nt - 2);
            const char* a1 = cA + (size_t)(t + 1) * kstep;
            const char* a2 = last ? nA : cA + (size_t)(t + 2) * kstep; const char* b2 = last ? nB : cB + (size_t)(t + 2) * kstep;
            const char* a3 = a2 + kstep; const char* b3 = b2 + kstep;
            PG8_LDB(B0, 0, 0); PG8_LDB(B1, 0, 1); PG8_SCHED; PG8_LDA(At, 0, 0); PG8_STAGE(PG8_SA(1, 1), a1 + hstepA, voffA);
            PG8_WAIT_V(8); PG8_WAIT_L(0); PG8_BAR; PG8_MMA(0, 0, At, B0); PG8_MMA(0, 1, At, B1); PG8_BAR; PG8_SCHED;
            PG8_LDA(At, 0, 1); PG8_STAGE(PG8_SB(0, 0), b2, voffB); PG8_STAGE(PG8_SB(0, 1), b2 + hstepB, voffB); PG8_STAGE(PG8_SA(0, 0), a2, voffA);
            PG8_WAIT_V(8); PG8_WAIT_L(0); PG8_BAR; PG8_MMA(1, 0, At, B0); PG8_MMA(1, 1, At, B1); PG8_BAR; PG8_SCHED;
            PG8_LDB(B0, 1, 0); PG8_LDB(B1, 1, 1); PG8_SCHED; PG8_LDA(At, 1, 0); PG8_STAGE(PG8_SA(0, 1), a2 + hstepA, voffA);
            PG8_WAIT_V(8); PG8_WAIT_L(0); PG8_BAR; PG8_MMA(0, 0, At, B0); PG8_MMA(0, 1, At, B1); PG8_BAR; PG8_SCHED;
            PG8_LDA(At, 1, 1); PG8_STAGE(PG8_SB(1, 0), b3, voffB); PG8_STAGE(PG8_SB(1, 1), b3 + hstepB, voffB); PG8_STAGE(PG8_SA(1, 0), a3, voffA);
            PG8_WAIT_V(8); PG8_WAIT_L(0); PG8_BAR; PG8_MMA(1, 0, At, B0); PG8_MMA(1, 1, At, B1); PG8_BAR; PG8_SCHED;
        }
        if (wr == 0) PG8_BAR;
#pragma unroll
        for (int ai = 0; ai < 2; ++ai)
#pragma unroll
            for (int m = 0; m < 4; ++m)
#pragma unroll
                for (int bj = 0; bj < 2; ++bj)
#pragma unroll
                    for (int n = 0; n < 2; ++n) E.store4(cur, ai * HALF + wr * 64 + m * 16 + fr, bj * HALF + wc * 32 + n * 16 + 4 * fq, acc[ai][bj][m][n]);
        if (!has_next) break;
#pragma unroll
        for (int a = 0; a < 2; ++a)
#pragma unroll
            for (int b = 0; b < 2; ++b)
#pragma unroll
                for (int m = 0; m < 4; ++m)
#pragma unroll
                    for (int n = 0; n < 2; ++n) acc[a][b][m][n] = (f32x4){0.f, 0.f, 0.f, 0.f};
        cur = nxt; cA = nA; cB = nB; ++ui;
        if (wr == 1) PG8_BAR;
    }
    PG8_WAIT_V(0);
    PG8_BAR;
#undef PG8_SA
#undef PG8_SB
#undef PG8_STAGE
#undef PG8_LDA
#undef PG8_LDB
#undef PG8_MMA
#undef PG8_WAIT_V
#undef PG8_WAIT_L
#undef PG8_BAR
#undef PG8_SCHED
}
}
#ifndef USE_FAST_NSA
#define USE_FAST_NSA 1
#endif
#ifndef USE_MFMA_GEMM
#define USE_MFMA_GEMM 1
#endif
template <class Sched, class Epi> __device__ __forceinline__ void run_gemm(Frame& F, const Sched& S, const Epi& E) {
#if USE_MFMA_GEMM
    pg8::gemm_phase(F.lds, S, E); __syncthreads();
#else
    naive_gemm(F, S, E);
#endif
}

template <class ColMap>
__device__ __forceinline__ void transpose_item(const float* W, int ldw, bf16_t* WT, int ldt, int k0, int n0, float scale, LAS float* scr, int lane, const ColMap& cm) {
    const int sc = cm(n0 + (lane & 31));
#pragma unroll 8
    for (int i = 0; i < 32; ++i) { const int kk = 2 * i + (lane >> 5); scr[kk * 33 + (lane & 31)] = sc >= 0 ? W[(size_t)(k0 + kk) * ldw + sc] * scale : 0.0f; }
    asm volatile("s_waitcnt lgkmcnt(0)" ::: "memory");
    const int c = lane & 7;
#pragma unroll
    for (int j = 0; j < 4; ++j) { const int n = (lane >> 3) + 8 * j; const LAS float* s = scr + (8 * c) * 33 + n;
        u32x4 o; o.x = pk2(s[0 * 33], s[1 * 33]); o.y = pk2(s[2 * 33], s[3 * 33]); o.z = pk2(s[4 * 33], s[5 * 33]); o.w = pk2(s[6 * 33], s[7 * 33]);
        *(u32x4*)(WT + (size_t)(n0 + n) * ldt + k0 + 8 * c) = o; }
    asm volatile("s_waitcnt lgkmcnt(0)" ::: "memory");
}
struct CmId { __device__ int operator()(int n) const { return n; } };
struct CmWin { __device__ int operator()(int n) const { return orig_col(n); } };

__device__ __forceinline__ void p0_prologue(Frame& F) {
    unsigned char* ws = F.ws;
    LAS float* scr = (LAS float*)(F.lds + F.wave * 16384);
    const int gw = F.bid * NWAVES + F.wave, NGW = F.G * NWAVES;
    bf16_t* WinT = (bf16_t*)(ws + WS_WIN); bf16_t* WoutT = (bf16_t*)(ws + WS_WOUT); bf16_t* WqkT = (bf16_t*)(ws + WS_WQK); bf16_t* W1T = (bf16_t*)(ws + WS_W1T); bf16_t* W2T = (bf16_t*)(ws + SM_W2T);
    constexpr int I_IN = (DM / 64) * (NPAD / 32), I_OUT = (DM / 64) * (DM / 32), I_QK = 8 * (256 / 64) * (256 / 32), I_W1 = 2 * (2048 / 64) * (128 / 32), I_W2 = 2 * (128 / 64) * (64 / 32);
    constexpr int NITEMS = I_IN + I_OUT + I_QK + I_W1 + I_W2;
    for (int it = gw; it < NITEMS; it += NGW) {
        int r = it;
        if (r < I_IN) { const int nb = r % (NPAD / 32), kb = r / (NPAD / 32); transpose_item(F.in[I_WIN], DIN, WinT, DM, kb * 64, nb * 32, 1.0f, scr, F.lane, CmWin()); continue; } r -= I_IN;
        if (r < I_OUT) { const int nb = r % (DM / 32), kb = r / (DM / 32); transpose_item(F.in[I_WOUT], DM, WoutT, DM, kb * 64, nb * 32, 1.0f, scr, F.lane, CmId()); continue; } r -= I_OUT;
        if (r < I_QK) { const int m = r / 32, rr = r % 32, h = m >> 1, sel = m & 1, kb = rr / 8, nb = rr % 8;
            transpose_item((sel ? F.in[I_WK] : F.in[I_WQ]) + (size_t)h * 65536, 256, WqkT + ((size_t)h * 512 + sel * 256) * 256, 256, kb * 64, nb * 32, sel ? 0.0625f : 1.0f, scr, F.lane, CmId()); continue; } r -= I_QK;
        if (r < I_W1) { const int kv = r / 128, rr = r % 128, kb = rr / 4, nb = rr % 4; transpose_item((kv ? F.in[I_W1V] : F.in[I_W1K]), 128, W1T + (size_t)kv * 128 * 2048, 2048, kb * 64, nb * 32, 1.0f, scr, F.lane, CmId()); continue; } r -= I_W1;
        { const int kv = r / 4, rr = r % 4, kb = rr / 2, nb = rr % 2; transpose_item((kv ? F.in[I_W2V] : F.in[I_W2K]), 64, W2T + (size_t)kv * 64 * 128, 128, kb * 64, nb * 32, 1.0f, scr, F.lane, CmId()); }
    }
    float* biasP = (float*)(ws + SM_BIASP);
    for (int c = F.bid * NTHREADS + F.tid; c < NPAD; c += F.G * NTHREADS) { const int oc = orig_col(c); biasP[c] = oc >= 0 ? F.in[I_BIN][oc] : 0.0f; }
    if (F.bid == F.G - 1 && F.tid < 256) {
        const int kv = F.tid >> 7, n = F.tid & 127; const float* pos = (kv ? F.in[I_POSV] : F.in[I_POSK]); const float* w1 = (kv ? F.in[I_W1V] : F.in[I_W1K]);
        float s = 0.f; for (int k = 0; k < 2048; ++k) s += pos[k] * w1[(size_t)k * 128 + n];
        ((float*)(ws + SM_C1))[kv * 128 + n] = s;
    }
    __syncthreads();
    LAS float* red = (LAS float*)F.lds;
    for (int it = F.bid; it < 192; it += F.G) {
        const int col = it * 32 + (F.lane & 31), kp = F.lane >> 5; float a0 = 0.f, a1 = 0.f;
        const float* c0 = F.in[I_C]; const float* w = F.in[I_WADA];
        for (int i = 0; i < 128; ++i) { const int k = F.wave * 256 + 2 * i + kp; const float wv = w[(size_t)k * 6144 + col]; a0 += siluf_(c0[k]) * wv; a1 += siluf_(c0[2048 + k]) * wv; }
        a0 += __shfl_xor(a0, 32); a1 += __shfl_xor(a1, 32);
        __syncthreads();
        if (F.lane < 32) { red[(F.wave * 2 + 0) * 32 + F.lane] = a0; red[(F.wave * 2 + 1) * 32 + F.lane] = a1; }
        __syncthreads();
        if (F.tid < 64) { const int b = F.tid >> 5, cc = F.tid & 31; float s = 0.f; for (int w8 = 0; w8 < 8; ++w8) s += red[(w8 * 2 + b) * 32 + cc];
            ((float*)(ws + SM_MOD))[b * 6144 + it * 32 + cc] = s + F.in[I_BADA][it * 32 + cc]; }
    }
    __syncthreads();
}

__device__ __forceinline__ void p1_norm(Frame& F) {
    const int gw = F.bid * NWAVES + F.wave, NGW = F.G * NWAVES;
    const float* mod = (const float*)(F.ws + SM_MOD); bf16_t* hb = (bf16_t*)(F.ws + WS_HB);
    for (int row = gw; row < MR; row += NGW) {
        const int b = row >> 12; const f32x4* xr = (const f32x4*)(F.in[I_X] + (size_t)row * DM) + F.lane;
        f32x4 v[8]; float ss = 0.f;
#pragma unroll
        for (int j = 0; j < 8; ++j) { v[j] = xr[64 * j]; ss += (v[j][0] * v[j][0] + v[j][1] * v[j][1]) + (v[j][2] * v[j][2] + v[j][3] * v[j][3]); }
        const float rstd = rsqrtf(wave_sum(ss) * (1.0f / DM) + EPS);
#pragma unroll
        for (int j = 0; j < 8; ++j) { const int col = 256 * j + 4 * F.lane;
            const f32x4 g = *(const f32x4*)(F.in[I_LNG] + col), sh = *(const f32x4*)(mod + b * 6144 + col), sc = *(const f32x4*)(mod + b * 6144 + 2048 + col);
            const f32x4 h = v[j] * rstd * g * (sc + 1.0f) + sh;
            u32x2 w; w.x = pk2(h[0], h[1]); w.y = pk2(h[2], h[3]); *(u32x2*)(hb + (size_t)row * DM + col) = w; }
    }
}

__device__ __forceinline__ void p3_conv(Frame& F) {
    const bf16_t* P = (const bf16_t*)(F.ws + WS_P); bf16_t* XC = (bf16_t*)(F.ws + WS_XC);
    const float* cw = F.in[I_CONVW]; const float* cb = F.in[I_CONVB];
    for (int idx = F.bid * NTHREADS + F.tid; idx < MR * 128; idx += F.G * NTHREADS) {
        const int row = idx >> 7, c0 = (idx & 127) * 8, t = row & 4095;
        float acc[8];
#pragma unroll
        for (int e = 0; e < 8; ++e) acc[e] = cb[c0 + e];
#pragma unroll
        for (int j = 0; j < 4; ++j) { if (t - 3 + j >= 0) { const u32x4 w = *(const u32x4*)(P + (size_t)(row - 3 + j) * PW + PC_MX + c0);
#pragma unroll
                for (int e = 0; e < 4; ++e) { acc[2 * e] += __uint_as_float(w[e] << 16) * cw[j * 1024 + c0 + 2 * e]; acc[2 * e + 1] += __uint_as_float(w[e] & 0xffff0000u) * cw[j * 1024 + c0 + 2 * e + 1]; } } }
        u32x4 o;
#pragma unroll
        for (int e = 0; e < 4; ++e) o[e] = pk2(siluf_(acc[2 * e]), siluf_(acc[2 * e + 1]));
        *(u32x4*)(XC + (size_t)row * 1024 + c0) = o;
    }
}
__device__ __forceinline__ void p3_gates(Frame& F) {
    if (F.bid >= 8) return;
    const int bh = F.bid, b = bh >> 2, h = bh & 3; const float* GF = (const float*)(F.ws + WS_GF);
    float* aArr = (float*)(F.ws + WS_GATE); float* AArr = aArr + 8 * T; float* BArr = AArr + 8 * T;
    LAS float* sc = (LAS float*)F.lds;
    const float fb = F.in[I_FBIAS][h];
    float lf[8], ig[8]; float run = 0.f;
#pragma unroll
    for (int e = 0; e < 8; ++e) { const int t = F.tid * 8 + e; const float* g = GF + (size_t)(b * T + t) * 64; ig[e] = g[h]; run += logsigmoidf_(g[4 + h] + fb); lf[e] = run; }
    sc[F.tid] = run; __syncthreads();
    if (F.tid == 0) { float s = 0.f; for (int i = 0; i < 512; ++i) { const float v = sc[i]; sc[i] = s; s += v; } }
    __syncthreads();
    const float base = sc[F.tid]; float av[8]; float mx = -INFINITY;
#pragma unroll
    for (int e = 0; e < 8; ++e) { lf[e] += base; av[e] = ig[e] - lf[e]; mx = fmaxf(mx, av[e]); }
    sc[512 + F.tid] = mx; __syncthreads();
    if (F.tid == 0) { float s = 0.0f; for (int i = 0; i < 512; ++i) { const float v = sc[512 + i]; sc[512 + i] = s; s = fmaxf(s, v); } }
    __syncthreads();
    float cm = sc[512 + F.tid];
#pragma unroll
    for (int e = 0; e < 8; ++e) { const int t = F.tid * 8 + e; cm = fmaxf(cm, av[e]); aArr[bh * T + t] = av[e]; AArr[bh * T + t] = cm; BArr[bh * T + t] = lf[e]; }
    __syncthreads();
}
__device__ __forceinline__ void p3_compress_naive(Frame& F) {
    const bf16_t* P = (const bf16_t*)(F.ws + WS_P); bf16_t* kcmp = (bf16_t*)(F.ws + WS_CMP); bf16_t* vcmpT = kcmp + 2 * 4 * 256 * 64;
    const bf16_t* W1T = (const bf16_t*)(F.ws + WS_W1T); const bf16_t* W2T = (const bf16_t*)(F.ws + SM_W2T); const float* c1 = (const float*)(F.ws + SM_C1);
    LAS float* hid = (LAS float*)F.lds;
    const int sub = F.tid >> 7, n = F.tid & 127;
    for (int it0 = F.bid * 4; it0 < 2 * 2 * 4 * 256; it0 += F.G * 4) {
        const int it = it0 + sub, j = it & 255, g = (it >> 8) & 3, b = (it >> 10) & 1, kv = it >> 11;
        float s = 0.f;
        if (j < NCMP) {
            const bf16_t* w = W1T + ((size_t)kv * 128 + n) * 2048; const bf16_t* xb = P + (size_t)(b * T + 16 * j) * PW + (kv ? PC_VC : PC_KC) + g * 64;
            for (int l = 0; l < 32; ++l) for (int d = 0; d < 64; ++d) s += bf2f(xb[(size_t)l * PW + d]) * bf2f(w[l * 64 + d]);
            s = gelu_tanh(s + c1[kv * 128 + n]);
        }
        __syncthreads(); hid[sub * 128 + n] = bf2f((bf16_t)f2bf(s)); __syncthreads();
        if (n < 64) { float o = 0.f; const bf16_t* w2 = W2T + ((size_t)kv * 64 + n) * 128; for (int q = 0; q < 128; ++q) o += hid[sub * 128 + q] * bf2f(w2[q]);
            if (j >= NCMP) o = 0.f;
            if (kv == 0) kcmp[(((size_t)b * 4 + g) * 256 + j) * 64 + n] = (bf16_t)f2bf(o); else vcmpT[(((size_t)b * 4 + g) * 64 + n) * 256 + j] = (bf16_t)f2bf(o); }
    }
    __syncthreads();
}
__device__ __forceinline__ void p3_nsa_vt_naive(Frame& F) {
    const bf16_t* P = (const bf16_t*)(F.ws + WS_P); bf16_t* vsT = (bf16_t*)(F.ws + WS_NVS); bf16_t* vwT = (bf16_t*)(F.ws + WS_NVW);
    for (int idx = F.bid * NTHREADS + F.tid; idx < 2 * 2 * 4 * 64 * T; idx += F.G * NTHREADS) {
        const int t = idx & 4095, d = (idx >> 12) & 63, g = (idx >> 18) & 3, b = (idx >> 20) & 1, sel = idx >> 21;
        const bf16_t v = P[(size_t)(b * T + t) * PW + (sel ? PC_VW : PC_VS) + g * 64 + d];
        (sel ? vwT : vsT)[(((size_t)b * 4 + g) * 64 + d) * T + t] = v;
    }
}
__device__ __forceinline__ void p4_mv_naive(Frame& F) {
    const bf16_t* P = (const bf16_t*)(F.ws + WS_P); bf16_t* VsT = (bf16_t*)(F.ws + WS_VST); bf16_t* Bt2 = (bf16_t*)(F.ws + WS_BT2);
    const float* aArr = (const float*)(F.ws + WS_GATE); const float* AArr = aArr + 8 * T;
    for (int idx = F.bid * NTHREADS + F.tid; idx < 8 * 256 * T; idx += F.G * NTHREADS) {
        const int t = idx & 4095, e = (idx >> 12) & 255, bh = idx >> 20, b = bh >> 2, h = bh & 3, ch = t >> 8;
        const float v = bf2f(P[(size_t)(b * T + t) * PW + PC_MV + h * 256 + e]);
        const float wkv = __expf(aArr[bh * T + t] - AArr[bh * T + ch * LC + LC - 1]);
        VsT[((size_t)bh * 256 + e) * T + t] = (bf16_t)f2bf(v * wkv);
        Bt2[(((size_t)bh * 16 + ch) * 256 + e) * 512 + (t & 255)] = (bf16_t)f2bf(v);
    }
}
__device__ __forceinline__ void p5_nu(Frame& F) {
    const bf16_t* Kn = (const bf16_t*)(F.ws + WS_K); float* nU = (float*)(F.ws + SM_NU);
    const float* aArr = (const float*)(F.ws + WS_GATE); const float* AArr = aArr + 8 * T;
    for (int idx = F.bid * NTHREADS + F.tid; idx < 128 * 256; idx += F.G * NTHREADS) {
        const int d = idx & 255, u = idx >> 8, bh = u >> 4, ch = u & 15, b = bh >> 2, h = bh & 3; const float Ae = AArr[bh * T + ch * LC + LC - 1];
        float s = 0.f; for (int q = 0; q < LC; ++q) { const int t = ch * LC + q; s += __expf(aArr[bh * T + t] - Ae) * bf2f(Kn[(size_t)(b * T + t) * 1024 + h * 256 + d]); }
        nU[idx] = s;
    }
}
__device__ __forceinline__ void p6_scan(Frame& F) {
    const float* UT = (const float*)((unsigned char*)F.out + OUT_UT); bf16_t* Bt2 = (bf16_t*)(F.ws + WS_BT2);
    const float* aArr = (const float*)(F.ws + WS_GATE); const float* AArr = aArr + 8 * T;
    for (int idx = F.bid * NTHREADS + F.tid; idx < 8 * 256 * 64; idx += F.G * NTHREADS) {
        const int d4 = (idx & 63) * 4, e = (idx >> 6) & 255, bh = idx >> 14;
        f32x4 C = {0.f, 0.f, 0.f, 0.f};
        for (int ch = 0; ch < NCH; ++ch) {
            const size_t un = (size_t)bh * 16 + ch;
            u32x2 w; w.x = pk2(C[0], C[1]); w.y = pk2(C[2], C[3]); *(u32x2*)(Bt2 + (un * 256 + e) * 512 + 256 + d4) = w;
            const float Ap = ch ? AArr[bh * T + ch * LC - 1] : 0.0f, Ae = AArr[bh * T + ch * LC + LC - 1];
            C = C * __expf(Ap - Ae) + *(const f32x4*)(UT + (un * 256 + e) * 256 + d4);
        }
    }
}
__device__ __forceinline__ void p6_den(Frame& F) {
    const bf16_t* Q = (const bf16_t*)(F.ws + WS_Q); const bf16_t* A2 = (const bf16_t*)((unsigned char*)F.out + OUT_A2); const float* nU = (const float*)(F.ws + SM_NU);
    float* den = (float*)(F.ws + SM_DEN); const float* aArr = (const float*)(F.ws + WS_GATE); const float* AArr = aArr + 8 * T;
    LAS float* ncs = (LAS float*)F.lds;
    for (int u = F.bid; u < 128; u += F.G) {
        const int bh = u >> 4, ch = u & 15, b = bh >> 2, h = bh & 3;
        __syncthreads();
        if (F.tid < 256) { float n = 0.f; for (int j = 0; j < ch; ++j) { const float Ap = j ? AArr[bh * T + j * LC - 1] : 0.0f, Ae = AArr[bh * T + j * LC + LC - 1]; n = n * __expf(Ap - Ae) + nU[(bh * 16 + j) * 256 + F.tid]; } ncs[F.tid] = n; }
        __syncthreads();
        if (F.tid < 256) { const int t = ch * LC + F.tid, row = b * T + t; const float Ap = ch ? AArr[bh * T + ch * LC - 1] : 0.0f; const float wst = __expf(Ap - AArr[bh * T + t]);
            float dq = 0.f, ssum = 0.f;
            for (int d = 0; d < 256; ++d) dq += bf2f(Q[(size_t)row * 1024 + h * 256 + d]) * ncs[d];
            for (int s = 0; s < 256; ++s) ssum += bf2f(A2[(size_t)row * 2048 + h * 512 + s]);
            den[bh * T + t] = wst * dq + ssum; }
    }
    __syncthreads();
}
__device__ __forceinline__ void p8_mout(Frame& F) {
    const float* H = (const float*)((unsigned char*)F.out + OUT_UT); const bf16_t* P = (const bf16_t*)(F.ws + WS_P); const bf16_t* XC = (const bf16_t*)(F.ws + WS_XC); bf16_t* Y = (bf16_t*)(F.ws + WS_Y);
    const int gw = F.bid * NWAVES + F.wave, NGW = F.G * NWAVES;
    for (int it = gw; it < MR * 4; it += NGW) {
        const int row = it >> 2, h = it & 3, col = h * 256 + 4 * F.lane;
        const f32x4 v = *(const f32x4*)(H + (size_t)row * 1024 + col);
        const float mu = wave_sum((v[0] + v[1]) + (v[2] + v[3])) * (1.0f / 256.0f); const f32x4 dv = v - mu;
        const float var = wave_sum((dv[0] * dv[0] + dv[1] * dv[1]) + (dv[2] * dv[2] + dv[3] * dv[3])) * (1.0f / 256.0f); const float rs = rsqrtf(var + EPS);
        const u32x2 ow = *(const u32x2*)(P + (size_t)row * PW + PC_MO + col), zw = *(const u32x2*)(P + (size_t)row * PW + PC_MZ + col), xw = *(const u32x2*)(XC + (size_t)row * 1024 + col);
        float o[4];
#pragma unroll
        for (int e = 0; e < 4; ++e) { const unsigned oo = ow[e >> 1], zz = zw[e >> 1], xx = xw[e >> 1];
            const float om = (e & 1) ? __uint_as_float(oo & 0xffff0000u) : __uint_as_float(oo << 16), zm = (e & 1) ? __uint_as_float(zz & 0xffff0000u) : __uint_as_float(zz << 16), xc = (e & 1) ? __uint_as_float(xx & 0xffff0000u) : __uint_as_float(xx << 16);
            const float hn = dv[e] * rs * F.in[I_NORMW][col + e];
            o[e] = (sigmoidf_(om) * hn + F.in[I_SKIP][col + e] * xc) * siluf_(zm); }
        u32x2 w; w.x = pk2(o[0], o[1]); w.y = pk2(o[2], o[3]); *(u32x2*)(Y + (size_t)row * 2048 + col) = w;
    }
}
__device__ __forceinline__ void pn_nsa_naive(Frame& F) {
    const bf16_t* P = (const bf16_t*)(F.ws + WS_P); const float* GF = (const float*)(F.ws + WS_GF); bf16_t* Y = (bf16_t*)(F.ws + WS_Y);
    const bf16_t* kcmp = (const bf16_t*)(F.ws + WS_CMP); const bf16_t* vcmpT = kcmp + 2 * 4 * 256 * 64;
    LAS float* wl = (LAS float*)(F.lds + F.wave * 16384);
    LAS float* qs = wl;
    LAS float* pb = wl + 256;
    LAS float* pt = wl + 1280;
    LAS float* oc = wl + 1536;
    const int gw = F.bid * NWAVES + F.wave, NGW = F.G * NWAVES, lane = F.lane;
    for (int it = gw; it < MR * 4; it += NGW) {
        const int row = it >> 2, g = it & 3, b = row >> 12, t = row & 4095, cur = t >> 6;
        const bf16_t* prow = P + (size_t)row * PW;
#pragma unroll
        for (int hh = 0; hh < 4; ++hh) qs[hh * 64 + lane] = bf2f(prow[PC_NQ + (g * 4 + hh) * 64 + lane]) * 0.125f;
        for (int j = lane; j < 256; j += 64) pt[j] = 0.f;
        asm volatile("s_waitcnt lgkmcnt(0)" ::: "memory");
        const int ncv = (t >= 31) ? ((t - 31) >> 4) + 1 : 0;
        const bf16_t* kc = kcmp + ((size_t)b * 4 + g) * 256 * 64; const bf16_t* vc = vcmpT + ((size_t)b * 4 + g) * 64 * 256;
        for (int hh = 0; hh < 4; ++hh) {
            const float slope = exp2f(-0.5f * (float)(g * 4 + hh + 1));
            float sv[4]; float mx = -INFINITY;
#pragma unroll
            for (int jc = 0; jc < 4; ++jc) { const int j = jc * 64 + lane; float s = -INFINITY;
                if (j < ncv) { s = 0.f; for (int d = 0; d < 64; ++d) s += qs[hh * 64 + d] * bf2f(kc[j * 64 + d]); s -= slope * ((float)t - (16.0f * j + 15.5f)); }
                sv[jc] = s; mx = fmaxf(mx, s); }
            mx = wave_max(mx); if (!(mx > -INFINITY)) mx = 0.f;
            float z = 0.f;
#pragma unroll
            for (int jc = 0; jc < 4; ++jc) { sv[jc] = (jc * 64 + lane < ncv) ? __expf(sv[jc] - mx) : 0.f; z += sv[jc]; }
            z = wave_sum(z); const float iz = z > 0.f ? 1.0f / z : 1.0f;
#pragma unroll
            for (int jc = 0; jc < 4; ++jc) { const float p = sv[jc] * iz; pb[jc * 64 + lane] = p; pt[jc * 64 + lane] += p; }
            asm volatile("s_waitcnt lgkmcnt(0)" ::: "memory");
            float o = 0.f; for (int j = 0; j < ncv; ++j) o += pb[j] * bf2f(vc[lane * 256 + j]);
            oc[hh * 64 + lane] = o;
        }
        asm volatile("s_waitcnt lgkmcnt(0)" ::: "memory");
        float imp = 0.f;
        for (int j = 4 * lane - 1; j <= 4 * lane + 3; ++j) if (j >= 0 && j < NCMP) imp += pt[j];
        float v = (lane == 0 || lane == cur) ? INFINITY : (lane < cur ? imp : -INFINITY);
        int rank = 0;
        for (int s2 = 0; s2 < 64; ++s2) { const float o = __shfl(v, s2); rank += (o > v || (o == v && s2 < lane)) ? 1 : 0; }
        const unsigned long long mask = __ballot(rank < TOPN && lane <= cur);
        for (int hh = 0; hh < 4; ++hh) {
            const int head = g * 4 + hh; const float slope = exp2f(-0.5f * (float)(head + 1));
            int nb = 0; float mx = -INFINITY; unsigned long long mm = mask;
            while (mm) { const int s = __ffsll((long long)mm) - 1; mm &= mm - 1; const int pos = s * 64 + lane; float sc = -INFINITY;
                if (pos <= t) { const bf16_t* kr = P + (size_t)(b * T + pos) * PW + PC_KS + g * 64; sc = 0.f; for (int d = 0; d < 64; ++d) sc += qs[hh * 64 + d] * bf2f(kr[d]); sc -= slope * (float)(t - pos); }
                pb[nb * 64 + lane] = sc; mx = fmaxf(mx, sc); ++nb; }
            mx = wave_max(mx); if (!(mx > -INFINITY)) mx = 0.f;
            float z = 0.f;
            for (int i = 0; i < nb; ++i) { const float sc = pb[i * 64 + lane]; const float e = (sc > -INFINITY) ? __expf(sc - mx) : 0.f; pb[i * 64 + lane] = e; z += e; }
            z = wave_sum(z); const float izs = z > 0.f ? 1.0f / z : 1.0f;
            asm volatile("s_waitcnt lgkmcnt(0)" ::: "memory");
            float os = 0.f; mm = mask; int i2 = 0;
            while (mm) { const int s = __ffsll((long long)mm) - 1; mm &= mm - 1;
                for (int q = 0; q < 64; ++q) { const int pos = s * 64 + q; if (pos > t) break; os += pb[i2 * 64 + q] * bf2f(P[(size_t)(b * T + pos) * PW + PC_VS + g * 64 + lane]); }
                ++i2; }
            os *= izs;
            asm volatile("s_waitcnt lgkmcnt(0)" ::: "memory");
            float mw = -INFINITY;
            for (int i = 0; i < 8; ++i) { const int pos = t - 511 + i * 64 + lane; float sc = -INFINITY;
                if (pos >= 0) { const bf16_t* kr = P + (size_t)(b * T + pos) * PW + PC_KW + g * 64; sc = 0.f; for (int d = 0; d < 64; ++d) sc += qs[hh * 64 + d] * bf2f(kr[d]); sc -= slope * (float)(t - pos); }
                pb[i * 64 + lane] = sc; mw = fmaxf(mw, sc); }
            mw = wave_max(mw);
            float zw = 0.f;
            for (int i = 0; i < 8; ++i) { const float sc = pb[i * 64 + lane]; const float e = (sc > -INFINITY) ? __expf(sc - mw) : 0.f; pb[i * 64 + lane] = e; zw += e; }
            zw = wave_sum(zw); const float izw = zw > 0.f ? 1.0f / zw : 1.0f;
            asm volatile("s_waitcnt lgkmcnt(0)" ::: "memory");
            float ow = 0.f;
            for (int q = 0; q < 512; ++q) { const int pos = t - 511 + q; if (pos < 0) continue; ow += pb[q] * bf2f(P[(size_t)(b * T + pos) * PW + PC_VW + g * 64 + lane]); }
            ow *= izw;
            asm volatile("s_waitcnt lgkmcnt(0)" ::: "memory");
            const float* gl = GF + (size_t)row * 64 + 8 + g * 12 + hh * 3;
            const float o = sigmoidf_(gl[0]) * oc[hh * 64 + lane] + sigmoidf_(gl[1]) * os + sigmoidf_(gl[2]) * ow;
            const float zn = bf2f(prow[PC_NZ + head * 64 + lane]);
            Y[(size_t)row * 2048 + 1024 + head * 64 + lane] = (bf16_t)f2bf(o * siluf_(zn));
        }
        asm volatile("s_waitcnt lgkmcnt(0)" ::: "memory");
    }
}
namespace nsa {
typedef float f32x16 __attribute__((ext_vector_type(16)));
constexpr int KSTRB = 144, VSTRB = 136;
constexpr int L_K = 0, L_V = 9216, L_G = 18432, L_L = L_G + 64 * 65 * 4, L_SEL = L_L + 64 * 65 * 4, L_OT = L_SEL + 512, L_END = L_OT + 8 * 32 * 64 * 4;
enum { T_CMP1 = 0, T_CMP2 = 1, T_SLC = 2, T_WIN = 3 };

struct Ctx {
    const bf16_t* P; const bf16_t* kcmp; const bf16_t* vcmpT; const bf16_t* vsT; const bf16_t* vwT;
    int b, g;
};
__device__ __forceinline__ void tile_src(const Ctx& c, int type, int s, const bf16_t*& k, int& ks, const bf16_t*& v, int& vs) {
    if (type <= T_CMP2) { k = c.kcmp + (((size_t)c.b * 4 + c.g) * 256 + 64 * s) * 64; ks = 64; v = c.vcmpT + ((size_t)c.b * 4 + c.g) * 64 * 256 + 64 * s; vs = 256; }
    else if (type == T_SLC) { k = c.P + ((size_t)c.b * T + 64 * s) * PW + PC_KS + c.g * 64; ks = PW; v = c.vsT + ((size_t)c.b * 4 + c.g) * 64 * T + 64 * s; vs = T; }
    else { k = c.P + ((size_t)c.b * T + 64 * s) * PW + PC_KW + c.g * 64; ks = PW; v = c.vwT + ((size_t)c.b * 4 + c.g) * 64 * T + 64 * s; vs = T; }
}
__device__ __forceinline__ bf16x8 pack8(float a0, float a1, float a2, float a3, float a4, float a5, float a6, float a7) {
    u32x4 w; w.x = pk2(a0, a1); w.y = pk2(a2, a3); w.z = pk2(a4, a5); w.w = pk2(a6, a7); return __builtin_bit_cast(bf16x8, w);
}

#define NSA_SB() __builtin_amdgcn_sched_barrier(0)
template <int TY>
__device__ __forceinline__ void block_compute(LAS unsigned char* lds, const bf16x8 (&qf)[4], f32x16 (&o)[2], float& m, float& l, float linv, int csb, int t, float slope, bool selb,
                                              int r32, int half, int hh, int tl_) {
    f32x16 s0 = (f32x16){}, s1 = (f32x16){};
#pragma unroll
    for (int ks = 0; ks < 4; ++ks) {
        const bf16x8 a0 = *(const LAS bf16x8*)(lds + L_K + r32 * KSTRB + (ks * 16 + half * 8) * 2);
        const bf16x8 a1 = *(const LAS bf16x8*)(lds + L_K + (32 + r32) * KSTRB + (ks * 16 + half * 8) * 2);
        s0 = __builtin_amdgcn_mfma_f32_32x32x16_bf16(a0, qf[ks], s0, 0, 0, 0);
        s1 = __builtin_amdgcn_mfma_f32_32x32x16_bf16(a1, qf[ks], s1, 0, 0, 0);
    }
    NSA_SB();
    float bmax = -INFINITY;
    const int kb = 64 * csb + 4 * half;
#pragma unroll
    for (int tl = 0; tl < 2; ++tl)
#pragma unroll
        for (int i = 0; i < 16; ++i) {
            const int key = kb + 32 * tl + (i & 3) + 8 * (i >> 2);
            float v = (tl ? s1[i] : s0[i]) * 0.125f; bool ok;
            if (TY <= T_CMP2) { ok = (16 * key + 31 <= t); v -= slope * ((float)(t - 16 * key) - 15.5f); }
            else { ok = (key <= t) && (TY == T_SLC ? selb : (t - key < WIN)); v -= slope * (float)(t - key); }
            v = ok ? v : -INFINITY; bmax = fmaxf(bmax, v);
            if (tl) s1[i] = v; else s0[i] = v;
        }
    NSA_SB();
    if (TY == T_CMP2) {
        const float ms = (m == -INFINITY) ? 0.f : m;
#pragma unroll
        for (int i = 0; i < 16; ++i) { s0[i] = __expf(s0[i] - ms) * linv; s1[i] = __expf(s1[i] - ms) * linv; }
        NSA_SB();
#pragma unroll
        for (int tl = 0; tl < 2; ++tl)
#pragma unroll
            for (int q4 = 0; q4 < 4; ++q4) {
                const float p0 = tl ? s1[4 * q4] : s0[4 * q4], p1 = tl ? s1[4 * q4 + 1] : s0[4 * q4 + 1], p2 = tl ? s1[4 * q4 + 2] : s0[4 * q4 + 2], p3 = tl ? s1[4 * q4 + 3] : s0[4 * q4 + 3];
                float gs = (p0 + p1) + (p2 + p3), ls = p3;
                gs += __shfl_xor(gs, 1); gs += __shfl_xor(gs, 2); ls += __shfl_xor(ls, 1); ls += __shfl_xor(ls, 2);
                LAS float* gb_ = (LAS float*)(lds + L_G) + tl_ * 65 + 16 * csb + half;
                if (hh == 0) { gb_[8 * tl + 2 * q4] = gs; gb_[64 * 65 + 8 * tl + 2 * q4 + 1] = ls; }
            }
    } else {
        bmax = fmaxf(bmax, __shfl_xor(bmax, 32));
        const float mn = fmaxf(m, bmax), ms = (mn == -INFINITY) ? 0.f : mn;
        const float alpha = __expf(m - ms); m = mn;
        float ps = 0.f;
#pragma unroll
        for (int i = 0; i < 16; ++i) { s0[i] = __expf(s0[i] - ms); s1[i] = __expf(s1[i] - ms); ps += s0[i] + s1[i]; }
        l = l * alpha + ps;
        if (TY != T_CMP1) {
#pragma unroll
            for (int d = 0; d < 2; ++d) o[d] *= alpha;
        }
    }
    NSA_SB();
    if (TY != T_CMP1) {
        bf16x8 pf[4];
#pragma unroll
        for (int kk = 0; kk < 4; ++kk) { const int b8 = 8 * (kk & 1);
            pf[kk] = (kk >> 1) ? pack8(s1[b8], s1[b8 + 1], s1[b8 + 2], s1[b8 + 3], s1[b8 + 4], s1[b8 + 5], s1[b8 + 6], s1[b8 + 7])
                               : pack8(s0[b8], s0[b8 + 1], s0[b8 + 2], s0[b8 + 3], s0[b8 + 4], s0[b8 + 5], s0[b8 + 6], s0[b8 + 7]); }
        NSA_SB();
#pragma unroll
        for (int d = 0; d < 2; ++d) {
#pragma unroll
            for (int kk = 0; kk < 4; ++kk) {
                const u32x2 lo = *(const LAS u32x2*)(lds + L_V + (32 * d + r32) * VSTRB + (16 * kk + 4 * half) * 2);
                const u32x2 hi = *(const LAS u32x2*)(lds + L_V + (32 * d + r32) * VSTRB + (16 * kk + 8 + 4 * half) * 2);
                const bf16x8 af = __builtin_bit_cast(bf16x8, (u32x4){lo.x, lo.y, hi.x, hi.y});
                o[d] = __builtin_amdgcn_mfma_f32_32x32x16_bf16(af, pf[kk], o[d], 0, 0, 0);
            }
            NSA_SB();
        }
    }
}

__device__ __forceinline__ void unit(Frame& F, const Ctx& c, int qt) {
    LAS unsigned char* lds = F.lds;
    const int tid = F.tid, lane = F.lane, wv = F.wave, r32 = lane & 31, half = lane >> 5, hh = r32 & 3, tl_ = wv * 8 + (r32 >> 2);
    const int t = qt * 64 + tl_, row = c.b * T + t, head = c.g * 4 + hh, cur = qt;
    const float slope = exp2f(-0.5f * (float)(head + 1));
    float g0, g1, g2; { const float* gp = (const float*)(F.ws + WS_GF) + (size_t)row * 64 + 8 + c.g * 12 + hh * 3; g0 = sigmoidf_(gp[0]); g1 = sigmoidf_(gp[1]); g2 = sigmoidf_(gp[2]); }
    bf16x8 qf[4];
#pragma unroll
    for (int ks = 0; ks < 4; ++ks) qf[ks] = *(const bf16x8*)(c.P + (size_t)row * PW + PC_NQ + head * 64 + ks * 16 + half * 8);
    for (int i = tid; i < 2 * 64 * 65; i += NTHREADS) ((LAS float*)(lds + L_G))[i] = 0.f;
    f32x16 o[2];
#pragma unroll
    for (int d = 0; d < 2; ++d) o[d] = (f32x16){};
    LAS float* otl = (LAS float*)(lds + L_OT) + wv * 2048 + lane;
    float m = -INFINITY, l = 0.f, linv = 0.f;
    unsigned long long selrow = 0ull, uni = 0ull;
    const int lrow = tid >> 3, lch = tid & 7;
    u32x4 kreg = {0u, 0u, 0u, 0u}, vreg = {0u, 0u, 0u, 0u};
    const int ncb = (4 * qt + 2) / 64 + 1;
#pragma unroll 1
    for (int stage = 0; stage < 2; ++stage) {
        int ty = 0, sb = 0; bool have;
        unsigned long long rem = uni; int wi = qt >= 8 ? qt - 8 : 0; int ci = 0;
#define NSA_NEXT(TY, SB, HAVE) do { HAVE = true; \
            if (stage == 0) { if (ci < ncb) { TY = T_CMP1; SB = ci; } else if (ci < 2 * ncb) { TY = T_CMP2; SB = ci - ncb; } else HAVE = false; ++ci; } \
            else { if (rem) { TY = T_SLC; SB = __builtin_ctzll(rem); rem &= rem - 1; } else if (wi <= qt) { TY = T_WIN; SB = wi; ++wi; } else HAVE = false; } } while (0)
#define NSA_ISSUE(TY, SB) do { const bf16_t *kp_, *vp_; int ks_, vs_; tile_src(c, TY, SB, kp_, ks_, vp_, vs_); \
            kreg = *(const u32x4*)(kp_ + (size_t)lrow * ks_ + lch * 8); if (TY != T_CMP1) vreg = *(const u32x4*)(vp_ + (size_t)lrow * vs_ + lch * 8); } while (0)
        NSA_NEXT(ty, sb, have);
        if (have) NSA_ISSUE(ty, sb);
        int prev_ty = -1;
#pragma unroll 1
        while (have) {
            __syncthreads();
            *(LAS u32x4*)(lds + L_K + lrow * KSTRB + lch * 16) = kreg;
            if (ty != T_CMP1) { *(LAS u32x2*)(lds + L_V + lrow * VSTRB + lch * 16) = (u32x2){vreg.x, vreg.y}; *(LAS u32x2*)(lds + L_V + lrow * VSTRB + lch * 16 + 8) = (u32x2){vreg.z, vreg.w}; }
            __syncthreads();
            const int cty = ty, csb = sb;
            NSA_NEXT(ty, sb, have);
            if (have) NSA_ISSUE(ty, sb);
            if (cty != prev_ty) {
                if (cty == T_CMP2) { const float lt = l + __shfl_xor(l, 32); linv = lt > 0.f ? 1.0f / lt : 0.f; }
                if (cty == T_WIN) {
                    if (prev_ty == T_SLC) { const float lt = l + __shfl_xor(l, 32); const float sc = lt > 0.f ? g1 / lt : 0.f;
#pragma unroll
                        for (int d = 0; d < 2; ++d) {
#pragma unroll
                            for (int i = 0; i < 16; ++i) otl[(d * 16 + i) * 64] += o[d][i] * sc;
                            o[d] = (f32x16){}; } }
                    m = -INFINITY; l = 0.f;
                }
                prev_ty = cty;
            }
            NSA_SB();
            const bool selb = (selrow >> csb) & 1ull;
            switch (cty) {
                case T_CMP1: block_compute<T_CMP1>(lds, qf, o, m, l, linv, csb, t, slope, selb, r32, half, hh, tl_); break;
                case T_CMP2: block_compute<T_CMP2>(lds, qf, o, m, l, linv, csb, t, slope, selb, r32, half, hh, tl_); break;
                case T_SLC:  block_compute<T_SLC>(lds, qf, o, m, l, linv, csb, t, slope, selb, r32, half, hh, tl_); break;
                default:     block_compute<T_WIN>(lds, qf, o, m, l, linv, csb, t, slope, selb, r32, half, hh, tl_); break;
            }
            NSA_SB();
        }
#undef NSA_NEXT
#undef NSA_ISSUE
        if (stage == 0) {
#pragma unroll
            for (int d = 0; d < 2; ++d) {
#pragma unroll
                for (int i = 0; i < 16; ++i) otl[(d * 16 + i) * 64] = o[d][i] * g0;
                o[d] = (f32x16){}; }
            m = -INFINITY; l = 0.f;
            __syncthreads();
#pragma unroll 1
            for (int tk = 0; tk < 8; ++tk) {
                const int tok = wv * 8 + tk; unsigned long long msk;
                if (cur < TOPN) msk = (1ull << (cur + 1)) - 1ull;
                else {
                    const float iv = ((LAS float*)(lds + L_G))[tok * 65 + lane] + ((LAS float*)(lds + L_L))[tok * 65 + lane];
                    unsigned key = (lane == 0 || lane == cur) ? 0x7f800000u : (lane < cur ? (__float_as_uint(iv) & 0x7fffffc0u) : 0u);
                    key |= (unsigned)(63 - lane);
                    int rank = 0;
#pragma unroll
                    for (int s2 = 0; s2 < 64; ++s2) { const unsigned ok_ = (unsigned)__builtin_amdgcn_readlane((int)key, s2); rank += (ok_ > key) ? 1 : 0; }
                    msk = __ballot(rank < TOPN && lane <= cur);
                }
                if (lane == 0) ((LAS unsigned long long*)(lds + L_SEL))[tok] = msk;
            }
            __syncthreads();
            selrow = ((LAS unsigned long long*)(lds + L_SEL))[tl_];
            unsigned long long um = ((LAS unsigned long long*)(lds + L_SEL))[lane];
#pragma unroll
            for (int of = 1; of < 64; of <<= 1) { const unsigned lo = __shfl_xor((unsigned)um, of), hi = __shfl_xor((unsigned)(um >> 32), of); um |= ((unsigned long long)hi << 32) | lo; }
            uni = um;
        }
    }
    { const float lt = l + __shfl_xor(l, 32); const float sc = lt > 0.f ? g2 / lt : 0.f;
#pragma unroll
      for (int d = 0; d < 2; ++d)
#pragma unroll
          for (int i = 0; i < 16; ++i) o[d][i] = otl[(d * 16 + i) * 64] + o[d][i] * sc; }
    bf16_t* Y = (bf16_t*)(F.ws + WS_Y);
#pragma unroll
    for (int d = 0; d < 2; ++d)
#pragma unroll
        for (int q4 = 0; q4 < 4; ++q4) {
            const int d0 = 32 * d + 8 * q4 + 4 * half;
            const u32x2 zw = *(const u32x2*)(c.P + (size_t)row * PW + PC_NZ + head * 64 + d0);
            const float z0 = __uint_as_float(zw.x << 16), z1 = __uint_as_float(zw.x & 0xffff0000u), z2 = __uint_as_float(zw.y << 16), z3 = __uint_as_float(zw.y & 0xffff0000u);
            u32x2 w; w.x = pk2(o[d][4 * q4] * siluf_(z0), o[d][4 * q4 + 1] * siluf_(z1)); w.y = pk2(o[d][4 * q4 + 2] * siluf_(z2), o[d][4 * q4 + 3] * siluf_(z3));
            *(u32x2*)(Y + (size_t)row * 2048 + 1024 + head * 64 + d0) = w;
        }
    __syncthreads();
}
__device__ __forceinline__ void phase(Frame& F) {
    Ctx c; c.P = (const bf16_t*)(F.ws + WS_P); c.kcmp = (const bf16_t*)(F.ws + WS_CMP); c.vcmpT = c.kcmp + 2 * 4 * 256 * 64; c.vsT = (const bf16_t*)(F.ws + WS_NVS); c.vwT = (const bf16_t*)(F.ws + WS_NVW);
    for (int L2 = 2 * F.bid; L2 < 512; L2 += 2 * F.G)
        for (int i = 0; i < 2; ++i) { const int L = L2 >> 1; c.b = L >> 7; c.g = (L >> 5) & 3; unit(F, c, i ? 63 - (L & 31) : (L & 31)); }
}
}

__device__ __forceinline__ void p10_final(Frame& F) {
    const int gw = F.bid * NWAVES + F.wave, NGW = F.G * NWAVES;
    for (int row = gw; row < MR; row += NGW) {
        f32x4* xr = (f32x4*)(F.out + (size_t)row * DM) + F.lane; f32x4 v[8]; float ss = 0.f;
#pragma unroll
        for (int j = 0; j < 8; ++j) { v[j] = xr[64 * j]; ss += (v[j][0] * v[j][0] + v[j][1] * v[j][1]) + (v[j][2] * v[j][2] + v[j][3] * v[j][3]); }
        const float rstd = rsqrtf(wave_sum(ss) * (1.0f / DM) + EPS);
#pragma unroll
        for (int j = 0; j < 8; ++j) { const f32x4 g = *(const f32x4*)(F.in[I_FINALG] + 256 * j + 4 * F.lane); xr[64 * j] = v[j] * rstd * g; }
    }
}

#define XB_TMO      128
#define XB_XCNT(j)  (256  + 64 * (j))
#define XB_XSUB(j)  (1280 + 64 * (j))
#define XB_XGEN(j)  (2304 + 64 * (j))
#define XB_TOP      3328
#define XB_TOPGEN   3392
#define XCD_BAR_WORDS 3456
#define XB_SPIN_CAP (1u << 18)
__device__ __forceinline__ unsigned xb_ld(unsigned* p)              { return __hip_atomic_load(p, __ATOMIC_RELAXED, __HIP_MEMORY_SCOPE_AGENT); }
__device__ __forceinline__ unsigned xb_add(unsigned* p, unsigned v) { return __hip_atomic_fetch_add(p, v, __ATOMIC_RELAXED, __HIP_MEMORY_SCOPE_AGENT); }
__device__ __forceinline__ unsigned xb_xcc_id() { return (unsigned)__builtin_amdgcn_s_getreg((3 << 11) | 20) & 0xFu; }
#define XB_SPIN(cond, bar) do { unsigned _sp = 0; while (cond) { __builtin_amdgcn_s_sleep(1); \
    if ((++_sp & 255u) == 0u) { if (xb_ld(&(bar)[XB_TMO])) break; if (_sp > XB_SPIN_CAP) { atomicAdd(&(bar)[XB_TMO], 1u); break; } } } } while (0)
struct XcdBarrier { unsigned* bar; unsigned x; volatile LAS unsigned* st; };
__device__ __forceinline__ XcdBarrier xcd_barrier_post(unsigned* bar, volatile LAS unsigned* st) {
    XcdBarrier b; b.bar = bar; b.x = xb_xcc_id(); b.st = st;
    if (threadIdx.x == 0) (void)xb_add(&bar[XB_XCNT(b.x)], 1u);
    return b;
}
__device__ __forceinline__ void xcd_barrier_complete(unsigned* bar, unsigned x, unsigned& nloc, unsigned& nx) {
    const unsigned G = gridDim.x * gridDim.y * gridDim.z;
    unsigned sum, cnt, mine, sp = 0u;
    for (;;) {
        sum = 0u; cnt = 0u; mine = 0u;
#pragma unroll
        for (unsigned j = 0; j < 16; ++j) { const unsigned c = xb_ld(&bar[XB_XCNT(j)]); sum += c; cnt += (c > 0u) ? 1u : 0u; mine = (j == x) ? c : mine; }
        if (sum == G) break;
        __builtin_amdgcn_s_sleep(1);
        if ((++sp & 255u) == 0u) { if (xb_ld(&bar[XB_TMO])) break; if (sp > XB_SPIN_CAP) { atomicAdd(&bar[XB_TMO], 1u); break; } }
    }
    nloc = mine > 0u ? mine : 1u; nx = cnt > 0u ? cnt : 1u;
}
__device__ __forceinline__ void xcd_barrier(const XcdBarrier& b) {
    asm volatile("s_waitcnt vmcnt(0)" ::: "memory");
    __syncthreads();
    if (threadIdx.x == 0) {
        unsigned* bar = b.bar;
        __builtin_amdgcn_s_waitcnt(0);
        unsigned nloc = b.st[0], nx = b.st[1];
        if (nloc == 0u) { xcd_barrier_complete(bar, b.x, nloc, nx); b.st[0] = nloc; b.st[1] = nx; }
        const unsigned old = xb_add(&bar[XB_XSUB(b.x)], 1u);
        const unsigned gen = old / nloc;
        if (old + 1u == (gen + 1u) * nloc) {
            __builtin_amdgcn_fence(__ATOMIC_RELEASE, "agent");
            asm volatile("s_waitcnt vmcnt(0)" ::: "memory");
            const unsigned og = xb_add(&bar[XB_TOP], 1u);
            const unsigned tg = og / nx;
            if (og + 1u == (tg + 1u) * nx) xb_add(&bar[XB_TOPGEN], 1u);
            else XB_SPIN(xb_ld(&bar[XB_TOPGEN]) == tg, bar);
            __builtin_amdgcn_fence(__ATOMIC_ACQUIRE, "agent");
            xb_add(&bar[XB_XGEN(b.x)], 1u);
            asm volatile("s_waitcnt vmcnt(0)" ::: "memory");
        } else {
            XB_SPIN(xb_ld(&bar[XB_XGEN(b.x)]) == gen, bar);
            __builtin_amdgcn_fence(__ATOMIC_ACQUIRE, "agent");
            asm volatile("s_waitcnt vmcnt(0)" ::: "memory");
        }
    }
    __syncthreads();
}
constexpr int CW_BAR = 4096;
constexpr int MISC_OFF = 131072 + 320;

constexpr int NPHASE = 12;
__global__ void __launch_bounds__(NTHREADS, 2) fwd(Args args) {
    extern __shared__ __attribute__((aligned(16))) unsigned char lds[];
    Frame F; F.lds = (LAS unsigned char*)lds; F.tid = threadIdx.x; F.lane = F.tid & 63; F.wave = __builtin_amdgcn_readfirstlane(F.tid >> 6); F.G = gridDim.x; F.bid = blockIdx.x;
#pragma unroll
    for (int i = 0; i < 22; ++i) F.in[i] = args.in[i];
    F.out = args.out; F.ws = args.ws;
    unsigned char* ws = F.ws;
    const int lo = args.ph_lo, hi = args.ph_hi;
    volatile LAS unsigned* MISC = (volatile LAS unsigned*)(F.lds + MISC_OFF);
    for (int u = F.tid; u < (LDS_BYTES - 131072) / 4; u += NTHREADS) ((LAS unsigned*)(F.lds + 131072))[u] = 0u;
    __syncthreads();
    XcdBarrier bar = xcd_barrier_post((unsigned*)(ws + WS_CTL) + CW_BAR + args.li * XCD_BAR_WORDS, MISC + 8);
#define IN(k) (lo <= (k) && (k) < hi)
#define SEAM(k) do { if (IN(k) && IN((k) + 1)) xcd_barrier(bar); } while (0)
    if (IN(0)) p0_prologue(F);
    SEAM(0);
    if (IN(1)) p1_norm(F);
    SEAM(1);
    if (IN(2)) {
        SchedGrid S{(const bf16_t*)(ws + WS_HB), (const bf16_t*)(ws + WS_WIN), DM, DM, DM, MR / 256, NPAD / 256, F.G, F.bid};
        EpiInproj E{(bf16_t*)(ws + WS_P), (float*)(ws + WS_GF), (const float*)(ws + SM_BIASP)};
        run_gemm(F, S, E);
    }
    SEAM(2);
    if (IN(3)) { p3_conv(F); p3_gates(F); p3_compress_naive(F); p3_nsa_vt_naive(F); }
    SEAM(3);
    if (IN(4)) {
        const float* AArr = (const float*)(ws + WS_GATE) + 8 * T;
        { SchedQK S{(const bf16_t*)(ws + WS_XC), (const bf16_t*)(ws + WS_WQK), 0, F.G, F.bid, 1024, 256, 256}; EpiQ E{(bf16_t*)(ws + WS_Q), (bf16_t*)((unsigned char*)F.out + OUT_A2), AArr}; run_gemm(F, S, E); }
        { SchedQK S{(const bf16_t*)(ws + WS_XC), (const bf16_t*)(ws + WS_WQK), 1, F.G, F.bid, 1024, 256, 256}; EpiK E{(bf16_t*)(ws + WS_K)}; run_gemm(F, S, E); }
        { SchedKT S{(const bf16_t*)(ws + WS_XC), (const bf16_t*)(ws + WS_WQK), F.G, F.bid, 256, 1024, 256}; EpiKT E{(bf16_t*)(ws + WS_KT)}; run_gemm(F, S, E); }
        p4_mv_naive(F);
    }
    SEAM(4);
    if (IN(5)) {
        const float* aArr = (const float*)(ws + WS_GATE); const float* AArr = aArr + 8 * T;
        { SchedChunk S{(const bf16_t*)(ws + WS_Q), (const bf16_t*)(ws + WS_K), F.G, F.bid, 1024, 1024, 256, 0}; EpiS E{(bf16_t*)((unsigned char*)F.out + OUT_A2), aArr, AArr}; run_gemm(F, S, E); }
        { SchedChunk S{(const bf16_t*)(ws + WS_VST), (const bf16_t*)(ws + WS_KT), F.G, F.bid, T, T, 256, 1}; EpiUT E{(float*)((unsigned char*)F.out + OUT_UT)}; run_gemm(F, S, E); }
        p5_nu(F);
    }
    SEAM(5);
    if (IN(6)) { p6_scan(F); p6_den(F); }
    SEAM(6);
    if (IN(7)) {
        const float* aArr = (const float*)(ws + WS_GATE); const float* AArr = aArr + 8 * T; const float* BArr = AArr + 8 * T;
        SchedChunk S{(const bf16_t*)((unsigned char*)F.out + OUT_A2), (const bf16_t*)(ws + WS_BT2), F.G, F.bid, 2048, 512, 512, 2};
        EpiNum E{(float*)((unsigned char*)F.out + OUT_UT), (const float*)(ws + SM_DEN), AArr, BArr}; run_gemm(F, S, E);
    }
    SEAM(7);
    if (IN(8)) p8_mout(F);
    SEAM(8);
    if (IN(9)) {
#if USE_FAST_NSA
        nsa::phase(F);
#else
        pn_nsa_naive(F);
#endif
    }
    SEAM(9);
    if (IN(10)) {
        SchedGrid S{(const bf16_t*)(ws + WS_Y), (const bf16_t*)(ws + WS_WOUT), DM, DM, DM, MR / 256, DM / 256, F.G, F.bid};
        EpiOut E{F.in[I_X], (const float*)(ws + SM_MOD), F.out}; run_gemm(F, S, E);
    }
    SEAM(10);
    if (IN(11)) p10_final(F);
#undef IN
#undef SEAM
}

extern "C" void kernel_launch(void* const* d_in, const int* in_sizes, int n_in, void* d_out, int out_size, void* d_ws, size_t ws_size, hipStream_t stream) {
    static int grid = 0;
    if (grid == 0) {
        if (n_in != 22 || in_sizes[0] != MR * DM || out_size != MR * DM || ws_size < WS_END) { fprintf(stderr, "kernel_launch: unexpected shapes (n_in %d, in0 %d, out %d, ws %zu)\n", n_in, n_in > 0 ? in_sizes[0] : -1, out_size, ws_size); grid = -1; return; }
        int dev = 0, cus = 0;
        if (hipGetDevice(&dev) != hipSuccess || hipDeviceGetAttribute(&cus, hipDeviceAttributeMultiprocessorCount, dev) != hipSuccess) { grid = -1; return; }
        if (hipFuncSetAttribute((const void*)fwd, hipFuncAttributeMaxDynamicSharedMemorySize, LDS_BYTES) != hipSuccess) { fprintf(stderr, "kernel_launch: hipFuncSetAttribute failed\n"); grid = -1; return; }
        (void)hipGetLastError();
        grid = cus;
    }
    if (grid < 0) return;
    (void)hipMemsetAsync((char*)d_ws + WS_CTL, 0, CTL_ZERO_BYTES, stream);
    Args a{};
    for (int i = 0; i < 22; ++i) a.in[i] = (const float*)d_in[i];
    a.out = (float*)d_out; a.ws = (unsigned char*)d_ws;
#ifndef N_LAUNCH_PER_PHASE
    a.ph_lo = 0; a.ph_hi = NPHASE; a.li = 0;
    hipLaunchKernelGGL(fwd, dim3(grid), dim3(NTHREADS), LDS_BYTES, stream, a);
#else
    for (int ph = 0; ph < NPHASE; ++ph) {
        a.ph_lo = ph; a.ph_hi = ph + 1; a.li = ph;
        hipLaunchKernelGGL(fwd, dim3(grid), dim3(NTHREADS), LDS_BYTES, stream, a);
    }
#endif
}
```

```cpp
#include <hip/hip_runtime.h>
#include <cstdint>
#include <cstdio>

#define GAS __attribute__((address_space(1)))
#define LAS __attribute__((address_space(3)))
typedef unsigned short bf16_t;
typedef float f32x4 __attribute__((ext_vector_type(4)));
typedef float f32x2 __attribute__((ext_vector_type(2)));
typedef unsigned u32x4 __attribute__((ext_vector_type(4)));
typedef unsigned u32x2 __attribute__((ext_vector_type(2)));
typedef short bf16x8 __attribute__((ext_vector_type(8)));

constexpr int NB = 2, T = 4096, DM = 2048, MR = NB * T;
constexpr int DIN = 7736, NPAD = 7936, PW = 7680;
constexpr int MW = 1024, MH = 4, MHD = 256;
constexpr int NHEADS = 16, NHD = 64, NG = 4, HPG = 4;
constexpr int NCMP = 255, NSLC = 64, TOPN = 16, WIN = 512;
constexpr int LC = 256, NCH = T / LC;
constexpr int PC_MX = 0, PC_MV = 1024, PC_MO = 2048, PC_MZ = 3072, PC_NQ = 4096, PC_KC = 5120, PC_VC = 5376, PC_KS = 5632, PC_VS = 5888, PC_KW = 6144, PC_VW = 6400, PC_NZ = 6656;
constexpr float EPS = 1e-6f;

constexpr size_t MiB = 1u << 20;
constexpr size_t WS_CTL = 0, CTL_ZERO_BYTES = 1 * MiB;
constexpr size_t WS_SMALL = 1 * MiB;
constexpr size_t SM_BIASP = WS_SMALL + 0 * 65536, SM_MOD = WS_SMALL + 1 * 65536, SM_C1 = WS_SMALL + 2 * 65536, SM_W2T = WS_SMALL + 3 * 65536,
                 SM_NU = WS_SMALL + 4 * 65536  , SM_DEN = WS_SMALL + 8 * 65536  ;
constexpr size_t WS_WQK = 2 * MiB, WS_W1T = 3 * MiB, WS_GF = 4 * MiB, WS_GATE = 6 * MiB, WS_CMP = 7 * MiB, WS_WOUT = 8 * MiB, WS_WIN = 16 * MiB, WS_HB = 48 * MiB;
constexpr size_t WS_XC = 16 * MiB, WS_Q = 32 * MiB, WS_K = 48 * MiB, WS_KT = 64 * MiB, WS_Y = 32 * MiB;
constexpr size_t WS_P = 80 * MiB, WS_VST = 200 * MiB, WS_BT2 = 216 * MiB, WS_NVS = 248 * MiB, WS_NVW = 252 * MiB, WS_END = 256 * MiB;
constexpr size_t WS_CT = 216 * MiB, WS_WQKP = 232 * MiB, WS_NUP = 236 * MiB, WS_DENP = 237 * MiB;
constexpr size_t WS_MODP = 246 * MiB;
constexpr size_t WS_KSC = 238 * MiB, WS_KWC = 242 * MiB;
constexpr size_t OUT_SB = 0, OUT_QS = 16 * MiB;
constexpr size_t OUT_A2 = 0, OUT_UT = 32 * MiB;
static_assert(WS_P + (size_t)MR * PW * 2 <= WS_VST && WS_WIN + (size_t)NPAD * DM * 2 <= WS_HB && WS_KT + 16 * MiB <= WS_P, "ws map");

__device__ __forceinline__ float bf2f(bf16_t b) { return __uint_as_float((unsigned)b << 16); }
__device__ __forceinline__ unsigned f2bf(float f) { unsigned u = __float_as_uint(f); return (u + 0x7fffu + ((u >> 16) & 1u)) >> 16; }
__device__ __forceinline__ unsigned pk2(float lo, float hi) { return f2bf(lo) | (f2bf(hi) << 16); }
#define WR_DPP(v, ctrl) __int_as_float(__builtin_amdgcn_mov_dpp(__float_as_int(v), (ctrl), 0xF, 0xF, true))
__device__ __forceinline__ float wave_sum(float v) {
    v += WR_DPP(v, 0xB1); v += WR_DPP(v, 0x4E); v += WR_DPP(v, 0x141); v += WR_DPP(v, 0x140);
    { const auto rr = __builtin_amdgcn_permlane16_swap(__float_as_uint(v), __float_as_uint(v), false, false); v = __uint_as_float(rr[0]) + __uint_as_float(rr[1]); }
    { const auto rr = __builtin_amdgcn_permlane32_swap(__float_as_uint(v), __float_as_uint(v), false, false); v = __uint_as_float(rr[0]) + __uint_as_float(rr[1]); }
    return v;
}
__device__ __forceinline__ float wave_max(float v) {
    v = fmaxf(v, WR_DPP(v, 0xB1)); v = fmaxf(v, WR_DPP(v, 0x4E)); v = fmaxf(v, WR_DPP(v, 0x141)); v = fmaxf(v, WR_DPP(v, 0x140));
    { const auto rr = __builtin_amdgcn_permlane16_swap(__float_as_uint(v), __float_as_uint(v), false, false); v = fmaxf(__uint_as_float(rr[0]), __uint_as_float(rr[1])); }
    { const auto rr = __builtin_amdgcn_permlane32_swap(__float_as_uint(v), __float_as_uint(v), false, false); v = fmaxf(__uint_as_float(rr[0]), __uint_as_float(rr[1])); }
    return v;
}
__device__ __forceinline__ float sigmoidf_(float x) { return 1.0f / (1.0f + __expf(-x)); }
__device__ __forceinline__ float siluf_(float x) { return x / (1.0f + __expf(-x)); }
__device__ __forceinline__ float gelu_tanh(float x) { const float u = 0.7978845608028654f * (x + 0.044715f * x * x * x); const float e = __expf(2.0f * u); return 0.5f * x * (1.0f + (1.0f - 2.0f / (e + 1.0f))); }
__device__ __forceinline__ float logsigmoidf_(float x) { return fminf(x, 0.0f) - log1pf(__expf(-fabsf(x))); }
__host__ __device__ __forceinline__ int orig_col(int c) {
    if (c < 4096) return c;
    if (c < 6656) return c + 8;
    if (c < 7680) return c + 56;
    if (c < 7688) return c - 3584;
    if (c < 7736) return c - 1024;
    return -1;
}

struct Args { const float* in[22]; float* out; unsigned char* ws; int ph_lo, ph_hi, li, pad; };
enum { I_X = 0, I_C, I_LNG, I_WADA, I_BADA, I_WIN, I_BIN, I_CONVW, I_CONVB, I_WQ, I_WK, I_NORMW, I_SKIP, I_FBIAS, I_POSK, I_POSV, I_W1K, I_W2K, I_W1V, I_W2V, I_WOUT, I_FINALG };

struct Frame {
    LAS unsigned char* lds;
    int tid, lane, wave, G, bid;
    const float* in[22]; float* out; unsigned char* ws;
};
constexpr int NWAVES = 8, NTHREADS = 512;
constexpr int LDS_BYTES = 147456;

struct Unit { int pm, pn; };
struct SchedGrid {
    static constexpr bool TWOSEG = false;
    const bf16_t* A; const bf16_t* Bt; int lda, ldb, K, nM, nN, G, c;
    __device__ bool next(int i, Unit& u) const { const long L = (long)i * G + c; if (L >= (long)nM * nN) return false; u.pm = (int)(L % nM); u.pn = (int)(L / nM); return true; }
    __device__ void ptrs(const Unit& u, const bf16_t*& a, const bf16_t*& b) const { a = A + (size_t)u.pm * 256 * lda; b = Bt + (size_t)u.pn * 256 * ldb; }
};

__host__ __device__ __forceinline__ bool inproj_swapped(int pn) { return (pn >= 4 && pn < 8) || pn == 23 || pn == 25; }
struct SchedInproj {
    static constexpr bool TWOSEG = false;
    const bf16_t* A; const bf16_t* Bt; int lda, ldb, K, G, c;
    __device__ bool next(int i, Unit& u) const { const long L = (long)i * G + c; if (L >= 32 * 31) return false; u.pm = (int)(L % 32); u.pn = (int)(L / 32); return true; }
    __device__ void ptrs(const Unit& u, const bf16_t*& a, const bf16_t*& b) const {
        const bf16_t* ta = A + (size_t)u.pm * 256 * lda; const bf16_t* tb = Bt + (size_t)u.pn * 256 * ldb;
        if (inproj_swapped(u.pn)) { a = tb; b = ta; } else { a = ta; b = tb; }
    }
};
struct EpiInproj {
    static constexpr bool ROWSUM = false;
    unsigned char* ws;
    __device__ __forceinline__ void store4(const Unit& u, int r, int c, f32x4 v) const {
        if (inproj_swapped(u.pn)) {
            const unsigned col = u.pn * 256 + r, row = u.pm * 256 + c, b = row >> 12, t = row & 4095;
            v = v + *(const float*)(ws + (unsigned)SM_BIASP + col * 4u);
            u32x2 w; w.x = pk2(v[0], v[1]); w.y = pk2(v[2], v[3]);
            unsigned off;
            if (u.pn < 8) off = (unsigned)WS_VST + (((b * 4u + (u.pn - 4)) * 256u + r) * T + t) * 2u;
            else off = (u.pn == 23 ? (unsigned)WS_NVS : (unsigned)WS_NVW) + ((((b * 4u + (r >> 6)) * 64u + (t >> 6)) * 64u + (r & 63)) * 64u + (t & 63)) * 2u;
            *(u32x2*)(ws + off) = w;
            return;
        }
        const unsigned row = u.pm * 256 + r, col = u.pn * 256 + c;
        v = v + *(const f32x4*)(ws + (unsigned)SM_BIASP + col * 4u);
        if (u.pn == 22 || u.pn == 24) { u32x2 w; w.x = pk2(v[0], v[1]); w.y = pk2(v[2], v[3]);
            *(u32x2*)(ws + ((u.pn == 22 ? (unsigned)WS_KSC : (unsigned)WS_KWC) + (((((row >> 12) * 4u + ((unsigned)c >> 6)) * T + (row & 4095u)) * 64u) + ((unsigned)c & 63u)) * 2u)) = w; }
        else if (u.pn < 30) { u32x2 w; w.x = pk2(v[0], v[1]); w.y = pk2(v[2], v[3]); *(u32x2*)(ws + ((unsigned)WS_P + (row * PW + col) * 2u)) = w; }
        else if (c < 64) { *(f32x4*)(ws + ((unsigned)WS_GF + (row * 64u + c) * 4u)) = v; }
    }
};
struct EpiP4 {
    static constexpr bool ROWSUM = true;
    unsigned char* ws; unsigned char* out;
    __device__ __forceinline__ float store4r(const Unit& u, int r, int c, f32x4 v) const {
        const unsigned h = u.pn & 3, ty = u.pn >> 2;
        const float* aArr = (const float*)(ws + WS_GATE); const float* AArr = aArr + 8 * T;
        if (ty == 2) {
            const unsigned tok = u.pm * 256 + c, b = tok >> 12, t = tok & 4095, bh = b * 4 + h;
            const float Ae = AArr[bh * T + (t | (LC - 1))]; const f32x4 as = *(const f32x4*)(aArr + bh * T + t);
#pragma unroll
            for (int i = 0; i < 4; ++i) v[i] *= __expf(as[i] - Ae);
            u32x2 w; w.x = pk2(v[0], v[1]); w.y = pk2(v[2], v[3]); *(u32x2*)(ws + ((unsigned)WS_KT + ((bh * 256u + r) * T + t) * 2u)) = w;
            return (v[0] + v[1]) + (v[2] + v[3]);
        }
        const unsigned row = u.pm * 256 + r, eo = (row * 1024u + h * 256u + c) * 2u;
        u32x2 w; w.x = pk2(v[0], v[1]); w.y = pk2(v[2], v[3]);
        if (ty == 1) { *(u32x2*)(ws + ((unsigned)WS_K + eo)) = w; return 0.f; }
        *(u32x2*)(ws + ((unsigned)WS_Q + eo)) = w;
        const unsigned b = row >> 12, t = row & 4095, bh = b * 4 + h, t0 = t & ~(unsigned)(LC - 1);
        const float Aprev = t0 ? AArr[bh * T + t0 - 1] : 0.0f; const float wsc = __expf(Aprev - AArr[bh * T + t]);
        v = v * wsc; w.x = pk2(v[0], v[1]); w.y = pk2(v[2], v[3]); *(u32x2*)(out + ((unsigned)OUT_QS + eo)) = w;
        return 0.f;
    }
    __device__ __forceinline__ void rowpart(const Unit& u, int r, int wc, float val) const {
        if ((u.pn >> 2) == 2) { const unsigned h = u.pn & 3, b = u.pm >> 4, ch = u.pm & 15; *(float*)(ws + ((unsigned)WS_NUP + ((((b * 4 + h) * 16 + ch) * 256 + r) * 4 + wc) * 4u)) = val; }
    }
};
struct SchedP4 {
    static constexpr bool TWOSEG = false;
    const bf16_t* XC; const bf16_t* W; int G, c; int lda, ldb, K;
    __device__ bool next(int i, Unit& u) const { const int L = i * G + c; if (L >= 384) return false; const int ty = L >> 7, idx = L & 127; u.pm = idx & 31; u.pn = (idx >> 5) + 4 * ty; return true; }
    __device__ void ptrs(const Unit& u, const bf16_t*& a, const bf16_t*& b) const {
        const int h = u.pn & 3, ty = u.pn >> 2; const bf16_t* x = XC + (size_t)u.pm * 256 * 1024 + h * 256; const bf16_t* w = W + ((size_t)h * 512 + (ty ? 256 : 0)) * 1024;
        if (ty == 2) { a = w; b = x; } else { a = x; b = w; }
    }
};
struct EpiS {
    static constexpr bool ROWSUM = true;
    bf16_t* SB; float* denp; const float* aArr; const float* AArr;
    __device__ __forceinline__ float store4r(const Unit& u, int r, int c, f32x4 v) const {
        const int bh = u.pm >> 4, ch = u.pm & 15, b = bh >> 2, h = bh & 3, t = ch * LC + r, row = b * T + t;
        const float At = AArr[bh * T + t]; const f32x4 as = *(const f32x4*)(aArr + bh * T + ch * LC + c);
#pragma unroll
        for (int i = 0; i < 4; ++i) v[i] = (c + i <= r) ? v[i] * __expf(as[i] - At) : 0.0f;
        u32x2 w; w.x = pk2(v[0], v[1]); w.y = pk2(v[2], v[3]); *(u32x2*)(SB + (size_t)row * 1024 + h * 256 + c) = w;
        return (__uint_as_float(w.x << 16) + __uint_as_float(w.x & 0xffff0000u)) + (__uint_as_float(w.y << 16) + __uint_as_float(w.y & 0xffff0000u));
    }
    __device__ __forceinline__ void rowpart(const Unit& u, int r, int wc, float val) const { const int bh = u.pm >> 4, ch = u.pm & 15; denp[((size_t)bh * T + ch * LC + r) * 4 + wc] = val; }
};
struct EpiUT {
    static constexpr bool ROWSUM = false;
    float* UT;
    __device__ __forceinline__ void store4(const Unit& u, int r, int c, f32x4 v) const { *(f32x4*)(UT + ((size_t)u.pm * 256 + r) * 256 + c) = v; }
};
struct EpiNum {
    static constexpr bool ROWSUM = false;
    float* H; const float* den; const float* AArr; const float* BArr;
    __device__ __forceinline__ void store4(const Unit& u, int r, int c, f32x4 v) const {
        const int bh = u.pm >> 4, ch = u.pm & 15, b = bh >> 2, h = bh & 3, t = ch * LC + r, row = b * T + t;
        const float d = fmaxf(fabsf(den[bh * T + t]), __expf(-(BArr[bh * T + t] + AArr[bh * T + t])));
        *(f32x4*)(H + (size_t)row * 1024 + h * 256 + c) = v * (1.0f / d);
    }
};
struct EpiOut {
    static constexpr bool ROWSUM = false;
    const float* x; const float* mod; float* out;
    __device__ __forceinline__ void store4(const Unit& u, int r, int c, f32x4 v) const {
        const int row = u.pm * 256 + r, col = u.pn * 256 + c, b = row >> 12;
        const f32x4 g = *(const f32x4*)(mod + b * 6144 + 4096 + col); const f32x4 xv = *(const f32x4*)(x + (size_t)row * DM + col);
        *(f32x4*)(out + (size_t)row * DM + col) = xv + g * v;
    }
};
struct SchedChunk {
    static constexpr bool TWOSEG = false;
    const bf16_t* A; const bf16_t* Bt; int G, c; int lda, ldb, K; int mode, first;
    __device__ bool next(int i, Unit& u) const { const int k0 = c >= first ? 0 : (first - c + G - 1) / G; const int L = c + (k0 + i) * G; if (L >= first + 128) return false; u.pm = L - first; u.pn = 0; return true; }
    __device__ void ptrs(const Unit& u, const bf16_t*& a, const bf16_t*& b) const {
        const int bh = u.pm >> 4, ch = u.pm & 15, bb = bh >> 2, h = bh & 3;
        if (mode == 0) { a = A + ((size_t)bb * T + ch * LC) * 1024 + h * 256; b = Bt + ((size_t)bb * T + ch * LC) * 1024 + h * 256; }
        else { a = A + (size_t)bh * 256 * T + ch * LC; b = Bt + (size_t)bh * 256 * T + ch * LC; }
    }
};
struct SchedNum {
    static constexpr bool TWOSEG = true;
    const bf16_t* SB; const bf16_t* QS; const bf16_t* VT; const bf16_t* CT; int G, c; int lda, ldb, K, K1;
    __device__ bool next(int i, Unit& u) const { const int L = i * G + c; if (L >= 128) return false; u.pm = L; u.pn = 0; return true; }
    __device__ void ptrs(const Unit& u, const bf16_t*& a, const bf16_t*& b) const { const int bh = u.pm >> 4, ch = u.pm & 15, bb = bh >> 2, h = bh & 3; a = SB + ((size_t)bb * T + ch * LC) * 1024 + h * 256; b = VT + (size_t)bh * 256 * T + ch * LC; }
    __device__ void ptrs2(const Unit& u, const bf16_t*& a, const bf16_t*& b) const { const int bh = u.pm >> 4, ch = u.pm & 15, bb = bh >> 2, h = bh & 3; a = QS + ((size_t)bb * T + ch * LC) * 1024 + h * 256; b = CT + (size_t)bh * 256 * T + ch * LC; }
};

namespace pg8 {
constexpr int BM = 256, BK = 64, HALF = 128, HTB = HALF * BK * 2, STAGE_BYTES = 8 * HTB;
__host__ __device__ __forceinline__ int lds_byte(int r, int c) { const int st = (r >> 4) * 2 + (c >> 5), rr = r & 15, cc = c & 31, ob = rr * 64 + cc * 2; return st * 1024 + (ob ^ (((ob >> 9) & 1) << 5)); }
__host__ __device__ __forceinline__ void stage_rc(int b, int& R, int& C) { const int st = b / 1024, sb = b % 1024, swz = sb ^ (((sb >> 9) & 1) << 5); R = (st >> 1) * 16 + swz / 64; C = (st & 1) * 32 + (swz % 64) / 2; }

template <class Sched> __device__ __forceinline__ int nt1_of(const Sched& S, int nt) { if constexpr (Sched::TWOSEG) return S.K1 / BK; else return nt; }
template <class Sched, class Epi>
__device__ __forceinline__ void gemm_phase(LAS unsigned char* lds, const Sched& S, const Epi& E) {
    const int tid = threadIdx.x, wid = __builtin_amdgcn_readfirstlane(tid >> 6), lane = tid & 63, wr = wid >> 2, wc = wid & 3, fr = lane & 15, fq = lane >> 4;
    const int nt = S.K / BK;
    unsigned voffA[2], voffB[2];
#pragma unroll
    for (int i = 0; i < 2; ++i) { int R, C; stage_rc(tid * 16 + i * 8192, R, C); voffA[i] = (unsigned)(R * S.lda + C) * 2u; voffB[i] = (unsigned)(R * S.ldb + C) * 2u; }
    const size_t kstep = (size_t)(BK * 2);
    const size_t hstepA = (size_t)HALF * S.lda * 2, hstepB = (size_t)HALF * S.ldb * 2;
    const unsigned ldsw = (unsigned)wid * 1024u;
    const int aoff = lds_byte(wr * 64 + fr, fq * 8), boff = lds_byte(wc * 32 + fr, fq * 8);
#define PG8_SA(b, h) (((b) * 2 + (h)) * HTB)
#define PG8_SB(b, h) ((4 + (b) * 2 + (h)) * HTB)
#define PG8_STAGE(bufoff, gbase, voff) do { _Pragma("unroll") for (int _i = 0; _i < 2; ++_i) \
        __builtin_amdgcn_global_load_lds((const unsigned*)((const char*)(gbase) + (voff)[_i]), (LAS unsigned*)(lds + (bufoff) + ldsw + _i * 8192), 16, 0, 0); } while (0)
#define PG8_LDA(dst, b, h) do { _Pragma("unroll") for (int m = 0; m < 4; ++m) _Pragma("unroll") for (int k = 0; k < 2; ++k) dst[m][k] = *(const LAS bf16x8*)(lds + PG8_SA(b, h) + aoff + m * 2048 + k * 1024); } while (0)
#define PG8_LDB(dst, b, h) do { _Pragma("unroll") for (int n = 0; n < 2; ++n) _Pragma("unroll") for (int k = 0; k < 2; ++k) dst[n][k] = *(const LAS bf16x8*)(lds + PG8_SB(b, h) + boff + n * 2048 + k * 1024); } while (0)
#define PG8_MMA(ai, bj, At, Bt) do { __builtin_amdgcn_s_setprio(1); _Pragma("unroll") for (int m = 0; m < 4; ++m) _Pragma("unroll") for (int n = 0; n < 2; ++n) _Pragma("unroll") for (int k = 0; k < 2; ++k) \
        acc[ai][bj][m][n] = __builtin_amdgcn_mfma_f32_16x16x32_bf16(Bt[n][k], At[m][k], acc[ai][bj][m][n], 0, 0, 0); __builtin_amdgcn_s_setprio(0); } while (0)
#define PG8_WAIT_V(n) asm volatile("s_waitcnt vmcnt(" #n ")" ::: "memory")
#define PG8_WAIT_L(n) asm volatile("s_waitcnt lgkmcnt(" #n ")" ::: "memory")
#define PG8_BAR __builtin_amdgcn_s_barrier()
#define PG8_SCHED __builtin_amdgcn_sched_barrier(0)
    Unit cur, nxt; int ui = 0;
    if (!S.next(0, cur)) return;
    f32x4 acc[2][2][4][2];
#pragma unroll
    for (int a = 0; a < 2; ++a)
#pragma unroll
        for (int b = 0; b < 2; ++b)
#pragma unroll
            for (int m = 0; m < 4; ++m)
#pragma unroll
                for (int n = 0; n < 2; ++n) acc[a][b][m][n] = (f32x4){0.f, 0.f, 0.f, 0.f};
    bf16x8 At[4][2], B0[2][2], B1[2][2];
    const bf16_t *pa, *pb; S.ptrs(cur, pa, pb);
    const char* cA = (const char*)pa; const char* cB = (const char*)pb;
    const int nt1 = nt1_of(S, nt);
    const char* cA2 = cA; const char* cB2 = cB;
    if constexpr (Sched::TWOSEG) { const bf16_t *qa, *qb; S.ptrs2(cur, qa, qb); cA2 = (const char*)qa - (size_t)nt1 * kstep; cB2 = (const char*)qb - (size_t)nt1 * kstep; }
#define PG8_TA(t) ((Sched::TWOSEG && (t) >= nt1 ? cA2 : cA) + (size_t)(t) * kstep)
#define PG8_TB(t) ((Sched::TWOSEG && (t) >= nt1 ? cB2 : cB) + (size_t)(t) * kstep)
    PG8_STAGE(PG8_SB(0, 0), cB, voffB); PG8_STAGE(PG8_SB(0, 1), cB + hstepB, voffB); PG8_STAGE(PG8_SA(0, 0), cA, voffA); PG8_STAGE(PG8_SA(0, 1), cA + hstepA, voffA);
    if (wr == 1) PG8_BAR;
    PG8_WAIT_V(2); PG8_BAR;
    PG8_STAGE(PG8_SB(1, 0), cB + kstep, voffB); PG8_STAGE(PG8_SA(1, 0), cA + kstep, voffA); PG8_STAGE(PG8_SB(1, 1), cB + hstepB + kstep, voffB);
    PG8_WAIT_V(6); PG8_BAR;
    for (;;) {
        const bool has_next = S.next(ui + 1, nxt);
        const char* nA = cA; const char* nB = cB; const char* nA2 = cA2; const char* nB2 = cB2;
        if (has_next) { const bf16_t *qa, *qb; S.ptrs(nxt, qa, qb); nA = (const char*)qa; nB = (const char*)qb;
            if constexpr (Sched::TWOSEG) { S.ptrs2(nxt, qa, qb); nA2 = (const char*)qa - (size_t)nt1 * kstep; nB2 = (const char*)qb - (size_t)nt1 * kstep; } }
        for (int t = 0; t < nt; t += 2) {
            const bool last = (t == nt - 2);
            const char* a1 = PG8_TA(t + 1);
            const char* a2 = last ? nA : PG8_TA(t + 2); const char* b2 = last ? nB : PG8_TB(t + 2);
            const char* a3 = last ? nA + kstep : PG8_TA(t + 3); const char* b3 = last ? nB + kstep : PG8_TB(t + 3);
            PG8_LDB(B0, 0, 0); PG8_LDB(B1, 0, 1); PG8_SCHED; PG8_LDA(At, 0, 0); PG8_STAGE(PG8_SA(1, 1), a1 + hstepA, voffA);
            PG8_WAIT_V(8); PG8_WAIT_L(0); PG8_BAR; PG8_MMA(0, 0, At, B0); PG8_MMA(0, 1, At, B1); PG8_BAR; PG8_SCHED;
            PG8_LDA(At, 0, 1); PG8_STAGE(PG8_SB(0, 0), b2, voffB); PG8_STAGE(PG8_SB(0, 1), b2 + hstepB, voffB); PG8_STAGE(PG8_SA(0, 0), a2, voffA);
            PG8_WAIT_V(8); PG8_WAIT_L(0); PG8_BAR; PG8_MMA(1, 0, At, B0); PG8_MMA(1, 1, At, B1); PG8_BAR; PG8_SCHED;
            PG8_LDB(B0, 1, 0); PG8_LDB(B1, 1, 1); PG8_SCHED; PG8_LDA(At, 1, 0); PG8_STAGE(PG8_SA(0, 1), a2 + hstepA, voffA);
            PG8_WAIT_V(8); PG8_WAIT_L(0); PG8_BAR; PG8_MMA(0, 0, At, B0); PG8_MMA(0, 1, At, B1); PG8_BAR; PG8_SCHED;
            PG8_LDA(At, 1, 1); PG8_STAGE(PG8_SB(1, 0), b3, voffB); PG8_STAGE(PG8_SB(1, 1), b3 + hstepB, voffB); PG8_STAGE(PG8_SA(1, 0), a3, voffA);
            PG8_WAIT_V(8); PG8_WAIT_L(0); PG8_BAR; PG8_MMA(1, 0, At, B0); PG8_MMA(1, 1, At, B1); PG8_BAR; PG8_SCHED;
        }
        if (wr == 0) PG8_BAR;
#pragma unroll
        for (int ai = 0; ai < 2; ++ai)
#pragma unroll
            for (int m = 0; m < 4; ++m) {
                float rs = 0.f;
#pragma unroll
                for (int bj = 0; bj < 2; ++bj)
#pragma unroll
                    for (int n = 0; n < 2; ++n) {
                        if constexpr (Epi::ROWSUM) rs += E.store4r(cur, ai * HALF + wr * 64 + m * 16 + fr, bj * HALF + wc * 32 + n * 16 + 4 * fq, acc[ai][bj][m][n]);
                        else E.store4(cur, ai * HALF + wr * 64 + m * 16 + fr, bj * HALF + wc * 32 + n * 16 + 4 * fq, acc[ai][bj][m][n]);
                    }
                if constexpr (Epi::ROWSUM) { { const auto rr = __builtin_amdgcn_permlane16_swap(__float_as_uint(rs), __float_as_uint(rs), false, false); rs = __uint_as_float(rr[0]) + __uint_as_float(rr[1]); }
                    { const auto rr = __builtin_amdgcn_permlane32_swap(__float_as_uint(rs), __float_as_uint(rs), false, false); rs = __uint_as_float(rr[0]) + __uint_as_float(rr[1]); } if (fq == 0) E.rowpart(cur, ai * HALF + wr * 64 + m * 16 + fr, wc, rs); }
            }
        if (!has_next) break;
#pragma unroll
        for (int a = 0; a < 2; ++a)
#pragma unroll
            for (int b = 0; b < 2; ++b)
#pragma unroll
                for (int m = 0; m < 4; ++m)
#pragma unroll
                    for (int n = 0; n < 2; ++n) acc[a][b][m][n] = (f32x4){0.f, 0.f, 0.f, 0.f};
        cur = nxt; cA = nA; cB = nB; cA2 = nA2; cB2 = nB2; ++ui;
        if (wr == 1) PG8_BAR;
    }
    PG8_WAIT_V(0);
    PG8_BAR;
#undef PG8_TA
#undef PG8_TB
#undef PG8_SA
#undef PG8_SB
#undef PG8_STAGE
#undef PG8_LDA
#undef PG8_LDB
#undef PG8_MMA
#undef PG8_WAIT_V
#undef PG8_WAIT_L
#undef PG8_BAR
#undef PG8_SCHED
}
}
#ifndef USE_FAST_NSA
#define USE_FAST_NSA 1
#endif
#ifndef USE_MFMA_GEMM
#define USE_MFMA_GEMM 1
#endif
template <class Sched, class Epi> __device__ __forceinline__ void run_gemm(Frame& F, const Sched& S, const Epi& E) {
    pg8::gemm_phase(F.lds, S, E); __syncthreads();
}

template <class ColMap>
__device__ __forceinline__ void transpose_item(const float* W, int ldw, bf16_t* WT, int ldt, int k0, int n0, float scale, LAS float* scr, int lane, const ColMap& cm) {
    const int sc = cm(n0 + (lane & 31));
    float tv[32];
#pragma unroll
    for (int i = 0; i < 32; ++i) { const int kk = 2 * i + (lane >> 5); tv[i] = sc >= 0 ? W[(size_t)(k0 + kk) * ldw + sc] : 0.0f; }
#pragma unroll
    for (int i = 0; i < 32; ++i) { const int kk = 2 * i + (lane >> 5); scr[kk * 33 + (lane & 31)] = tv[i] * scale; }
    asm volatile("s_waitcnt lgkmcnt(0)" ::: "memory");
    const int c = lane & 7;
#pragma unroll
    for (int j = 0; j < 4; ++j) { const int n = (lane >> 3) + 8 * j; const LAS float* s = scr + (8 * c) * 33 + n;
        u32x4 o; o.x = pk2(s[0 * 33], s[1 * 33]); o.y = pk2(s[2 * 33], s[3 * 33]); o.z = pk2(s[4 * 33], s[5 * 33]); o.w = pk2(s[6 * 33], s[7 * 33]);
        *(u32x4*)(WT + (size_t)(n0 + n) * ldt + k0 + 8 * c) = o; }
    asm volatile("s_waitcnt lgkmcnt(0)" ::: "memory");
}
struct CmId { __device__ int operator()(int n) const { return n; } };
struct CmWin { __device__ int operator()(int n) const { return orig_col(n); } };

__device__ __forceinline__ void p0_gemv_item(Frame& F, int item) {
    const int cg = item % 24, ks = item / 24; const float* c0 = F.in[I_C]; const float* w = F.in[I_WADA] + (size_t)(ks * 128) * 6144 + cg * 256 + 4 * F.lane;
    f32x4 a0 = {0.f, 0.f, 0.f, 0.f}, a1 = {0.f, 0.f, 0.f, 0.f};
#pragma unroll 1
    for (int kb = 0; kb < 128; kb += 16) {
        f32x4 wv[16];
#pragma unroll
        for (int i = 0; i < 16; ++i) wv[i] = *(const f32x4*)(w + (size_t)(kb + i) * 6144);
#pragma unroll
        for (int i = 0; i < 16; ++i) { const int k = ks * 128 + kb + i; const float s0 = siluf_(c0[k]), s1 = siluf_(c0[2048 + k]); a0 += wv[i] * s0; a1 += wv[i] * s1; }
    }
    float* part = (float*)(F.ws + WS_MODP) + (size_t)ks * 2 * 6144 + cg * 256 + 4 * F.lane;
    *(f32x4*)part = a0; *(f32x4*)(part + 6144) = a1;
}

__device__ __forceinline__ void p0_prologue(Frame& F) {
    unsigned char* ws = F.ws;
    LAS float* scr = (LAS float*)(F.lds + F.wave * 16384);
    const int gw = F.bid * NWAVES + F.wave, NGW = F.G * NWAVES;
    bf16_t* WinT = (bf16_t*)(ws + WS_WIN); bf16_t* WoutT = (bf16_t*)(ws + WS_WOUT); bf16_t* WqkT = (bf16_t*)(ws + WS_WQKP); bf16_t* W1T = (bf16_t*)(ws + WS_W1T); bf16_t* W2T = (bf16_t*)(ws + SM_W2T);
    constexpr int I_IN = (DM / 64) * (NPAD / 32), I_OUT = (DM / 64) * (DM / 32), I_QK = 8 * (256 / 64) * (256 / 32), I_W1 = 2 * (2048 / 64) * (128 / 32), I_W2 = 2 * (128 / 64) * (64 / 32);
    constexpr int NITEMS = I_IN + I_OUT + I_QK + I_W1 + I_W2;
    for (int it = gw; it < 384; it += NGW) p0_gemv_item(F, it);
    for (int it = gw; it < NITEMS; it += NGW) {
        int r = it;
        if (r < I_IN) { const int nb = r % (NPAD / 32), kb = r / (NPAD / 32); transpose_item(F.in[I_WIN], DIN, WinT, DM, kb * 64, nb * 32, 1.0f, scr, F.lane, CmWin()); continue; } r -= I_IN;
        if (r < I_OUT) { const int nb = r % (DM / 32), kb = r / (DM / 32); transpose_item(F.in[I_WOUT], DM, WoutT, DM, kb * 64, nb * 32, 1.0f, scr, F.lane, CmId()); continue; } r -= I_OUT;
        if (r < I_QK) { const int m = r / 32, rr = r % 32, h = m >> 1, sel = m & 1, kb = rr / 8, nb = rr % 8;
            transpose_item((sel ? F.in[I_WK] : F.in[I_WQ]) + (size_t)h * 65536, 256, WqkT + ((size_t)h * 512 + sel * 256) * 1024, 1024, kb * 64, nb * 32, sel ? 0.0625f : 1.0f, scr, F.lane, CmId()); continue; } r -= I_QK;
        if (r < I_W1) { const int kv = r / 128, rr = r % 128, kb = rr / 4, nb = rr % 4; transpose_item((kv ? F.in[I_W1V] : F.in[I_W1K]), 128, W1T + (size_t)kv * 128 * 2048, 2048, kb * 64, nb * 32, 1.0f, scr, F.lane, CmId()); continue; } r -= I_W1;
        { const int kv = r / 4, rr = r % 4, kb = rr / 2, nb = rr % 2; transpose_item((kv ? F.in[I_W2V] : F.in[I_W2K]), 64, W2T + (size_t)kv * 64 * 128, 128, kb * 64, nb * 32, 1.0f, scr, F.lane, CmId()); }
    }
    float* biasP = (float*)(ws + SM_BIASP);
    for (int c = F.bid * NTHREADS + F.tid; c < NPAD; c += F.G * NTHREADS) { const int oc = orig_col(c); biasP[c] = oc >= 0 ? F.in[I_BIN][oc] : 0.0f; }
    if (F.bid == F.G - 1 && F.tid < 256) {
        const int kv = F.tid >> 7, n = F.tid & 127; const float* pos = (kv ? F.in[I_POSV] : F.in[I_POSK]); const float* w1 = (kv ? F.in[I_W1V] : F.in[I_W1K]);
        float s = 0.f; for (int k = 0; k < 2048; ++k) s += pos[k] * w1[(size_t)k * 128 + n];
        ((float*)(ws + SM_C1))[kv * 128 + n] = s;
    }
    __syncthreads();
}
__device__ __forceinline__ void p1_norm(Frame& F) {
    const int gw = F.bid * NWAVES + F.wave, NGW = F.G * NWAVES;
    const float* part = (const float*)(F.ws + WS_MODP); bf16_t* hb = (bf16_t*)(F.ws + WS_HB);
    LAS float* gsl = (LAS float*)F.lds; LAS float* shl = gsl + 2 * 2048;
    for (int e = F.tid; e < 2048; e += NTHREADS) {
        const int c4 = (e & 511) * 4, which = (e >> 9) & 1, b = e >> 10, mc = which * 2048 + c4;
        f32x4 sacc = *(const f32x4*)(F.in[I_BADA] + mc);
#pragma unroll
        for (int ks = 0; ks < 16; ++ks) sacc += *(const f32x4*)(part + ((size_t)ks * 2 + b) * 6144 + mc);
        if (which) { const f32x4 g = *(const f32x4*)(F.in[I_LNG] + c4); *(LAS f32x4*)(gsl + b * 2048 + c4) = g * (sacc + 1.0f); } else *(LAS f32x4*)(shl + b * 2048 + c4) = sacc;
    }
    if (F.bid < 16 && F.tid < 64) { const int b = F.bid >> 3, mc = 4096 + (F.bid & 7) * 256 + 4 * F.tid;
        f32x4 sacc = *(const f32x4*)(F.in[I_BADA] + mc);
#pragma unroll
        for (int ks = 0; ks < 16; ++ks) sacc += *(const f32x4*)(part + ((size_t)ks * 2 + b) * 6144 + mc);
        *(f32x4*)((float*)(F.ws + SM_MOD) + b * 6144 + mc) = sacc; }
    __syncthreads();
    for (int row0 = gw; row0 < MR; row0 += 2 * NGW) {
        f32x4 v[2][8]; float ss[2] = {0.f, 0.f};
#pragma unroll
        for (int q = 0; q < 2; ++q) { const int row = row0 + q * NGW; const f32x4* xr = (const f32x4*)(F.in[I_X] + (size_t)row * DM) + F.lane;
#pragma unroll
            for (int j = 0; j < 8; ++j) v[q][j] = xr[64 * j]; }
#pragma unroll
        for (int q = 0; q < 2; ++q)
#pragma unroll
            for (int j = 0; j < 8; ++j) ss[q] += (v[q][j][0] * v[q][j][0] + v[q][j][1] * v[q][j][1]) + (v[q][j][2] * v[q][j][2] + v[q][j][3] * v[q][j][3]);
#pragma unroll
        for (int q = 0; q < 2; ++q) { const int row = row0 + q * NGW, b = row >> 12; const float rstd = rsqrtf(wave_sum(ss[q]) * (1.0f / DM) + EPS);
#pragma unroll
            for (int j = 0; j < 8; ++j) { const int col = 256 * j + 4 * F.lane;
                const f32x4 g = *(const LAS f32x4*)(gsl + b * 2048 + col), sh = *(const LAS f32x4*)(shl + b * 2048 + col);
                const f32x4 h = v[q][j] * rstd * g + sh;
                u32x2 w; w.x = pk2(h[0], h[1]); w.y = pk2(h[2], h[3]); *(u32x2*)(hb + (size_t)row * DM + col) = w; } }
    }
    __syncthreads();
}

__device__ __forceinline__ void p3_conv(Frame& F) {
    const bf16_t* P = (const bf16_t*)(F.ws + WS_P); bf16_t* XC = (bf16_t*)(F.ws + WS_XC);
    const float* cw = F.in[I_CONVW]; const float* cb = F.in[I_CONVB];
    for (int idx = F.bid * NTHREADS + F.tid; idx < MR * 128; idx += F.G * NTHREADS) {
        const int row = idx >> 7, c0 = (idx & 127) * 8, t = row & 4095;
        float acc[8];
#pragma unroll
        for (int e = 0; e < 8; ++e) acc[e] = cb[c0 + e];
#pragma unroll
        for (int j = 0; j < 4; ++j) { if (t - 3 + j >= 0) { const u32x4 w = *(const u32x4*)(P + (size_t)(row - 3 + j) * PW + PC_MX + c0);
#pragma unroll
                for (int e = 0; e < 4; ++e) { acc[2 * e] += __uint_as_float(w[e] << 16) * cw[j * 1024 + c0 + 2 * e]; acc[2 * e + 1] += __uint_as_float(w[e] & 0xffff0000u) * cw[j * 1024 + c0 + 2 * e + 1]; } } }
        u32x4 o;
#pragma unroll
        for (int e = 0; e < 4; ++e) o[e] = pk2(siluf_(acc[2 * e]), siluf_(acc[2 * e + 1]));
        *(u32x4*)(XC + (size_t)row * 1024 + c0) = o;
    }
}
__device__ __forceinline__ void p3_gates(Frame& F) {
    if (F.bid >= 8) return;
    const int bh = F.bid, b = bh >> 2, h = bh & 3; const float* GF = (const float*)(F.ws + WS_GF);
    float* aArr = (float*)(F.ws + WS_GATE); float* AArr = aArr + 8 * T; float* BArr = AArr + 8 * T;
    LAS float* sc = (LAS float*)F.lds;
    const float fb = F.in[I_FBIAS][h];
    float lf[8], ig[8]; float run = 0.f;
#pragma unroll
    for (int e = 0; e < 8; ++e) { const int t = F.tid * 8 + e; const float* g = GF + (size_t)(b * T + t) * 64; ig[e] = g[h]; run += logsigmoidf_(g[4 + h] + fb); lf[e] = run; }
    sc[F.tid] = run; __syncthreads();
    if (F.tid == 0) { float s = 0.f; for (int i = 0; i < 512; ++i) { const float v = sc[i]; sc[i] = s; s += v; } }
    __syncthreads();
    const float base = sc[F.tid]; float av[8]; float mx = -INFINITY;
#pragma unroll
    for (int e = 0; e < 8; ++e) { lf[e] += base; av[e] = ig[e] - lf[e]; mx = fmaxf(mx, av[e]); }
    sc[512 + F.tid] = mx; __syncthreads();
    if (F.tid == 0) { float s = 0.0f; for (int i = 0; i < 512; ++i) { const float v = sc[512 + i]; sc[512 + i] = s; s = fmaxf(s, v); } }
    __syncthreads();
    float cm = sc[512 + F.tid];
#pragma unroll
    for (int e = 0; e < 8; ++e) { const int t = F.tid * 8 + e; cm = fmaxf(cm, av[e]); aArr[bh * T + t] = av[e]; AArr[bh * T + t] = cm; BArr[bh * T + t] = lf[e]; }
    __syncthreads();
}
__device__ __forceinline__ void p3_compress_naive(Frame& F) {
    const bf16_t* P = (const bf16_t*)(F.ws + WS_P); bf16_t* kcmp = (bf16_t*)(F.ws + WS_CMP); bf16_t* vcmpT = kcmp + 2 * 4 * 256 * 64;
    const bf16_t* W1T = (const bf16_t*)(F.ws + WS_W1T); const bf16_t* W2T = (const bf16_t*)(F.ws + SM_W2T); const float* c1 = (const float*)(F.ws + SM_C1);
    LAS float* hid = (LAS float*)F.lds;
    const int sub = F.tid >> 7, n = F.tid & 127;
    for (int it0 = F.bid * 4; it0 < 2 * 2 * 4 * 256; it0 += F.G * 4) {
        const int it = it0 + sub, j = it & 255, g = (it >> 8) & 3, b = (it >> 10) & 1, kv = it >> 11;
        float s = 0.f;
        if (j < NCMP) {
            const bf16_t* w = W1T + ((size_t)kv * 128 + n) * 2048; const bf16_t* xb = P + (size_t)(b * T + 16 * j) * PW + (kv ? PC_VC : PC_KC) + g * 64;
            for (int l = 0; l < 32; ++l) for (int d = 0; d < 64; ++d) s += bf2f(xb[(size_t)l * PW + d]) * bf2f(w[l * 64 + d]);
            s = gelu_tanh(s + c1[kv * 128 + n]);
        }
        __syncthreads(); hid[sub * 128 + n] = bf2f((bf16_t)f2bf(s)); __syncthreads();
        if (n < 64) { float o = 0.f; const bf16_t* w2 = W2T + ((size_t)kv * 64 + n) * 128; for (int q = 0; q < 128; ++q) o += hid[sub * 128 + q] * bf2f(w2[q]);
            if (j >= NCMP) o = 0.f;
            if (kv == 0) kcmp[(((size_t)b * 4 + g) * 256 + j) * 64 + n] = (bf16_t)f2bf(o); else vcmpT[(((size_t)b * 4 + g) * 64 + n) * 256 + j] = (bf16_t)f2bf(o); }
    }
    __syncthreads();
}
__device__ __forceinline__ void p3_compress(Frame& F) {
    typedef float f32x4_ __attribute__((ext_vector_type(4)));
    const bf16_t* P = (const bf16_t*)(F.ws + WS_P); bf16_t* kcmp = (bf16_t*)(F.ws + WS_CMP); bf16_t* vcmpT = kcmp + 2 * 4 * 256 * 64;
    const bf16_t* W1T = (const bf16_t*)(F.ws + WS_W1T); const bf16_t* W2T = (const bf16_t*)(F.ws + SM_W2T); const float* c1 = (const float*)(F.ws + SM_C1);
    LAS unsigned char* lds = F.lds; constexpr int L_X = 0, L_H = 528 * 128;
    const int tid = F.tid, lane = F.lane, w = F.wave, fr = lane & 15, fq = lane >> 4;
    for (int un = F.bid; un < 128; un += F.G) {
        const int jt = un & 7, g = (un >> 3) & 3, b = (un >> 5) & 1, kv = un >> 6;
        const bf16_t* xb = P + (size_t)(b * T + 512 * jt) * PW + (kv ? PC_VC : PC_KC) + g * 64;
        __syncthreads();
        for (int e = tid; e < 528 * 8; e += NTHREADS) { const int r = e >> 3, ch = e & 7; u32x4 v = {0u, 0u, 0u, 0u};
            if (512 * jt + r < T) v = *(const u32x4*)(xb + (size_t)r * PW + ch * 8);
            *(LAS u32x4*)(lds + L_X + r * 128 + ((ch ^ ((r >> 4) & 7)) << 4)) = v; }
        __syncthreads();
        f32x4_ acc[2] = {(f32x4_){0.f, 0.f, 0.f, 0.f}, (f32x4_){0.f, 0.f, 0.f, 0.f}};
        const bf16_t* wrow = W1T + ((size_t)kv * 128 + 16 * w + fr) * 2048 + 8 * fq;
#pragma unroll 4
        for (int l = 0; l < 32; ++l) {
            const bf16x8 b0 = *(const bf16x8*)(wrow + l * 64), b1 = *(const bf16x8*)(wrow + l * 64 + 32);
#pragma unroll
            for (int rt = 0; rt < 2; ++rt) {
                const int r = 256 * rt + 16 * fr + l, sw = (r >> 4) & 7;
                const bf16x8 a0 = *(const LAS bf16x8*)(lds + L_X + r * 128 + ((fq ^ sw) << 4));
                const bf16x8 a1 = *(const LAS bf16x8*)(lds + L_X + r * 128 + (((4 + fq) ^ sw) << 4));
                acc[rt] = __builtin_amdgcn_mfma_f32_16x16x32_bf16(a0, b0, acc[rt], 0, 0, 0);
                acc[rt] = __builtin_amdgcn_mfma_f32_16x16x32_bf16(a1, b1, acc[rt], 0, 0, 0);
            }
        }
        { const float cb = c1[kv * 128 + 16 * w + fr];
#pragma unroll
          for (int rt = 0; rt < 2; ++rt)
#pragma unroll
              for (int r = 0; r < 4; ++r) *(LAS bf16_t*)(lds + L_H + ((16 * rt + 4 * fq + r) * 136 + 16 * w + fr) * 2) = (bf16_t)f2bf(gelu_tanh(acc[rt][r] + cb)); }
        __syncthreads();
        { const int rt = w >> 2, ct = w & 3; f32x4_ o = {0.f, 0.f, 0.f, 0.f};
          const bf16_t* w2 = W2T + ((size_t)kv * 64 + 16 * ct + fr) * 128 + 8 * fq;
#pragma unroll
          for (int ks = 0; ks < 4; ++ks) { const bf16x8 a = *(const LAS bf16x8*)(lds + L_H + ((16 * rt + fr) * 136 + 32 * ks + 8 * fq) * 2); const bf16x8 bb = *(const bf16x8*)(w2 + 32 * ks);
              o = __builtin_amdgcn_mfma_f32_16x16x32_bf16(a, bb, o, 0, 0, 0); }
          const int d = 16 * ct + fr, j0 = 32 * jt + 16 * rt + 4 * fq;
          if (kv == 0) {
#pragma unroll
              for (int r = 0; r < 4; ++r) kcmp[(((size_t)b * 4 + g) * 256 + j0 + r) * 64 + d] = (bf16_t)((j0 + r < NCMP) ? f2bf(o[r]) : 0u);
          } else { u32x2 wv; wv.x = pk2(o[0], o[1]); wv.y = pk2(o[2], (j0 + 3 < NCMP) ? o[3] : 0.f); *(u32x2*)(vcmpT + (((size_t)b * 4 + g) * 64 + d) * 256 + j0) = wv; }
        }
    }
    __syncthreads();
}
__device__ __forceinline__ void p3_nsa_vt_naive(Frame& F) {
    const bf16_t* P = (const bf16_t*)(F.ws + WS_P); bf16_t* vsT = (bf16_t*)(F.ws + WS_NVS); bf16_t* vwT = (bf16_t*)(F.ws + WS_NVW);
    for (int idx = F.bid * NTHREADS + F.tid; idx < 2 * 2 * 4 * 64 * T; idx += F.G * NTHREADS) {
        const int t = idx & 4095, d = (idx >> 12) & 63, g = (idx >> 18) & 3, b = (idx >> 20) & 1, sel = idx >> 21;
        const bf16_t v = P[(size_t)(b * T + t) * PW + (sel ? PC_VW : PC_VS) + g * 64 + d];
        (sel ? vwT : vsT)[(((size_t)b * 4 + g) * 64 + d) * T + t] = v;
    }
}
__device__ __forceinline__ void p6_scan(Frame& F) {
    const float* UT = (const float*)((unsigned char*)F.out + OUT_UT); bf16_t* CT = (bf16_t*)(F.ws + WS_CT);
    const float* aArr = (const float*)(F.ws + WS_GATE); const float* AArr = aArr + 8 * T;
    for (int idx = F.bid * NTHREADS + F.tid; idx < 8 * 256 * 64; idx += F.G * NTHREADS) {
        const int d4 = (idx & 63) * 4, e = (idx >> 6) & 255, bh = idx >> 14;
        f32x4 C = {0.f, 0.f, 0.f, 0.f};
        for (int ch = 0; ch < NCH; ++ch) {
            const size_t un = (size_t)bh * 16 + ch;
            u32x2 w; w.x = pk2(C[0], C[1]); w.y = pk2(C[2], C[3]); *(u32x2*)(CT + ((size_t)bh * 256 + e) * T + ch * LC + d4) = w;
            const float Ap = ch ? AArr[bh * T + ch * LC - 1] : 0.0f, Ae = AArr[bh * T + ch * LC + LC - 1];
            C = C * __expf(Ap - Ae) + *(const f32x4*)(UT + (un * 256 + e) * 256 + d4);
        }
    }
}
__device__ __forceinline__ void p6_den(Frame& F) {
    const bf16_t* QS = (const bf16_t*)((unsigned char*)F.out + OUT_QS); const f32x4* nUp = (const f32x4*)(F.ws + WS_NUP); const f32x4* denp = (const f32x4*)(F.ws + WS_DENP);
    float* den = (float*)(F.ws + SM_DEN); const float* aArr = (const float*)(F.ws + WS_GATE); const float* AArr = aArr + 8 * T;
    LAS float* ncs = (LAS float*)F.lds;
    for (int u = F.bid; u < 128; u += F.G) {
        const int bh = u >> 4, ch = u & 15, b = bh >> 2, h = bh & 3;
        __syncthreads();
        if (F.tid < 256) { float n = 0.f; for (int j = 0; j < ch; ++j) { const float Ap = j ? AArr[bh * T + j * LC - 1] : 0.0f, Ae = AArr[bh * T + j * LC + LC - 1]; const f32x4 p = nUp[(bh * 16 + j) * 256 + F.tid];
                n = n * __expf(Ap - Ae) + ((p[0] + p[1]) + (p[2] + p[3])); } ncs[F.tid] = n; }
        __syncthreads();
        const f32x4 nv = *(const LAS f32x4*)(ncs + 4 * F.lane);
        for (int rr = F.wave; rr < 256; rr += NWAVES) {
            const int t = ch * LC + rr, row = b * T + t;
            const u32x2 qw = *(const u32x2*)(QS + (size_t)row * 1024 + h * 256 + 4 * F.lane);
            float dq = (__uint_as_float(qw.x << 16) * nv[0] + __uint_as_float(qw.x & 0xffff0000u) * nv[1]) + (__uint_as_float(qw.y << 16) * nv[2] + __uint_as_float(qw.y & 0xffff0000u) * nv[3]);
            dq = wave_sum(dq);
            if (F.lane == 0) { const f32x4 p = denp[(size_t)bh * T + t]; den[bh * T + t] = dq + ((p[0] + p[1]) + (p[2] + p[3])); }
        }
    }
    __syncthreads();
}
__device__ __forceinline__ void p8_mout(Frame& F) {
    const float* H = (const float*)((unsigned char*)F.out + OUT_UT); const bf16_t* P = (const bf16_t*)(F.ws + WS_P); const bf16_t* XC = (const bf16_t*)(F.ws + WS_XC); bf16_t* Y = (bf16_t*)(F.ws + WS_Y);
    const int gw = F.bid * NWAVES + F.wave, NGW = F.G * NWAVES;
    for (int it = gw; it < MR * 4; it += NGW) {
        const int row = it >> 2, h = it & 3, col = h * 256 + 4 * F.lane;
        const f32x4 v = *(const f32x4*)(H + (size_t)row * 1024 + col);
        const float mu = wave_sum((v[0] + v[1]) + (v[2] + v[3])) * (1.0f / 256.0f); const f32x4 dv = v - mu;
        const float var = wave_sum((dv[0] * dv[0] + dv[1] * dv[1]) + (dv[2] * dv[2] + dv[3] * dv[3])) * (1.0f / 256.0f); const float rs = rsqrtf(var + EPS);
        const u32x2 ow = *(const u32x2*)(P + (size_t)row * PW + PC_MO + col), zw = *(const u32x2*)(P + (size_t)row * PW + PC_MZ + col), xw = *(const u32x2*)(XC + (size_t)row * 1024 + col);
        float o[4];
#pragma unroll
        for (int e = 0; e < 4; ++e) { const unsigned oo = ow[e >> 1], zz = zw[e >> 1], xx = xw[e >> 1];
            const float om = (e & 1) ? __uint_as_float(oo & 0xffff0000u) : __uint_as_float(oo << 16), zm = (e & 1) ? __uint_as_float(zz & 0xffff0000u) : __uint_as_float(zz << 16), xc = (e & 1) ? __uint_as_float(xx & 0xffff0000u) : __uint_as_float(xx << 16);
            const float hn = dv[e] * rs * F.in[I_NORMW][col + e];
            o[e] = (sigmoidf_(om) * hn + F.in[I_SKIP][col + e] * xc) * siluf_(zm); }
        u32x2 w; w.x = pk2(o[0], o[1]); w.y = pk2(o[2], o[3]); *(u32x2*)(Y + (size_t)row * 2048 + col) = w;
    }
}
__device__ __forceinline__ void pn_nsa_naive(Frame& F) {
    const bf16_t* P = (const bf16_t*)(F.ws + WS_P); const float* GF = (const float*)(F.ws + WS_GF); bf16_t* Y = (bf16_t*)(F.ws + WS_Y);
    const bf16_t* kcmp = (const bf16_t*)(F.ws + WS_CMP); const bf16_t* vcmpT = kcmp + 2 * 4 * 256 * 64;
    LAS float* wl = (LAS float*)(F.lds + F.wave * 16384);
    LAS float* qs = wl;
    LAS float* pb = wl + 256;
    LAS float* pt = wl + 1280;
    LAS float* oc = wl + 1536;
    const int gw = F.bid * NWAVES + F.wave, NGW = F.G * NWAVES, lane = F.lane;
    for (int it = gw; it < MR * 4; it += NGW) {
        const int row = it >> 2, g = it & 3, b = row >> 12, t = row & 4095, cur = t >> 6;
        const bf16_t* prow = P + (size_t)row * PW;
#pragma unroll
        for (int hh = 0; hh < 4; ++hh) qs[hh * 64 + lane] = bf2f(prow[PC_NQ + (g * 4 + hh) * 64 + lane]) * 0.125f;
        for (int j = lane; j < 256; j += 64) pt[j] = 0.f;
        asm volatile("s_waitcnt lgkmcnt(0)" ::: "memory");
        const int ncv = (t >= 31) ? ((t - 31) >> 4) + 1 : 0;
        const bf16_t* kc = kcmp + ((size_t)b * 4 + g) * 256 * 64; const bf16_t* vc = vcmpT + ((size_t)b * 4 + g) * 64 * 256;
        for (int hh = 0; hh < 4; ++hh) {
            const float slope = exp2f(-0.5f * (float)(g * 4 + hh + 1));
            float sv[4]; float mx = -INFINITY;
#pragma unroll
            for (int jc = 0; jc < 4; ++jc) { const int j = jc * 64 + lane; float s = -INFINITY;
                if (j < ncv) { s = 0.f; for (int d = 0; d < 64; ++d) s += qs[hh * 64 + d] * bf2f(kc[j * 64 + d]); s -= slope * ((float)t - (16.0f * j + 15.5f)); }
                sv[jc] = s; mx = fmaxf(mx, s); }
            mx = wave_max(mx); if (!(mx > -INFINITY)) mx = 0.f;
            float z = 0.f;
#pragma unroll
            for (int jc = 0; jc < 4; ++jc) { sv[jc] = (jc * 64 + lane < ncv) ? __expf(sv[jc] - mx) : 0.f; z += sv[jc]; }
            z = wave_sum(z); const float iz = z > 0.f ? 1.0f / z : 1.0f;
#pragma unroll
            for (int jc = 0; jc < 4; ++jc) { const float p = sv[jc] * iz; pb[jc * 64 + lane] = p; pt[jc * 64 + lane] += p; }
            asm volatile("s_waitcnt lgkmcnt(0)" ::: "memory");
            float o = 0.f; for (int j = 0; j < ncv; ++j) o += pb[j] * bf2f(vc[lane * 256 + j]);
            oc[hh * 64 + lane] = o;
        }
        asm volatile("s_waitcnt lgkmcnt(0)" ::: "memory");
        float imp = 0.f;
        for (int j = 4 * lane - 1; j <= 4 * lane + 3; ++j) if (j >= 0 && j < NCMP) imp += pt[j];
        float v = (lane == 0 || lane == cur) ? INFINITY : (lane < cur ? imp : -INFINITY);
        int rank = 0;
        for (int s2 = 0; s2 < 64; ++s2) { const float o = __shfl(v, s2); rank += (o > v || (o == v && s2 < lane)) ? 1 : 0; }
        const unsigned long long mask = __ballot(rank < TOPN && lane <= cur);
        for (int hh = 0; hh < 4; ++hh) {
            const int head = g * 4 + hh; const float slope = exp2f(-0.5f * (float)(head + 1));
            int nb = 0; float mx = -INFINITY; unsigned long long mm = mask;
            while (mm) { const int s = __ffsll((long long)mm) - 1; mm &= mm - 1; const int pos = s * 64 + lane; float sc = -INFINITY;
                if (pos <= t) { const bf16_t* kr = P + (size_t)(b * T + pos) * PW + PC_KS + g * 64; sc = 0.f; for (int d = 0; d < 64; ++d) sc += qs[hh * 64 + d] * bf2f(kr[d]); sc -= slope * (float)(t - pos); }
                pb[nb * 64 + lane] = sc; mx = fmaxf(mx, sc); ++nb; }
            mx = wave_max(mx); if (!(mx > -INFINITY)) mx = 0.f;
            float z = 0.f;
            for (int i = 0; i < nb; ++i) { const float sc = pb[i * 64 + lane]; const float e = (sc > -INFINITY) ? __expf(sc - mx) : 0.f; pb[i * 64 + lane] = e; z += e; }
            z = wave_sum(z); const float izs = z > 0.f ? 1.0f / z : 1.0f;
            asm volatile("s_waitcnt lgkmcnt(0)" ::: "memory");
            float os = 0.f; mm = mask; int i2 = 0;
            while (mm) { const int s = __ffsll((long long)mm) - 1; mm &= mm - 1;
                for (int q = 0; q < 64; ++q) { const int pos = s * 64 + q; if (pos > t) break; os += pb[i2 * 64 + q] * bf2f(P[(size_t)(b * T + pos) * PW + PC_VS + g * 64 + lane]); }
                ++i2; }
            os *= izs;
            asm volatile("s_waitcnt lgkmcnt(0)" ::: "memory");
            float mw = -INFINITY;
            for (int i = 0; i < 8; ++i) { const int pos = t - 511 + i * 64 + lane; float sc = -INFINITY;
                if (pos >= 0) { const bf16_t* kr = P + (size_t)(b * T + pos) * PW + PC_KW + g * 64; sc = 0.f; for (int d = 0; d < 64; ++d) sc += qs[hh * 64 + d] * bf2f(kr[d]); sc -= slope * (float)(t - pos); }
                pb[i * 64 + lane] = sc; mw = fmaxf(mw, sc); }
            mw = wave_max(mw);
            float zw = 0.f;
            for (int i = 0; i < 8; ++i) { const float sc = pb[i * 64 + lane]; const float e = (sc > -INFINITY) ? __expf(sc - mw) : 0.f; pb[i * 64 + lane] = e; zw += e; }
            zw = wave_sum(zw); const float izw = zw > 0.f ? 1.0f / zw : 1.0f;
            asm volatile("s_waitcnt lgkmcnt(0)" ::: "memory");
            float ow = 0.f;
            for (int q = 0; q < 512; ++q) { const int pos = t - 511 + q; if (pos < 0) continue; ow += pb[q] * bf2f(P[(size_t)(b * T + pos) * PW + PC_VW + g * 64 + lane]); }
            ow *= izw;
            asm volatile("s_waitcnt lgkmcnt(0)" ::: "memory");
            const float* gl = GF + (size_t)row * 64 + 8 + g * 12 + hh * 3;
            const float o = sigmoidf_(gl[0]) * oc[hh * 64 + lane] + sigmoidf_(gl[1]) * os + sigmoidf_(gl[2]) * ow;
            const float zn = bf2f(prow[PC_NZ + head * 64 + lane]);
            Y[(size_t)row * 2048 + 1024 + head * 64 + lane] = (bf16_t)f2bf(o * siluf_(zn));
        }
        asm volatile("s_waitcnt lgkmcnt(0)" ::: "memory");
    }
}
namespace nsa {
typedef float f32x16 __attribute__((ext_vector_type(16)));
typedef __bf16 bf16x2_t __attribute__((ext_vector_type(2)));
constexpr int KSTRB = 144, VSTRB = 136;
constexpr int KBUF = 64 * KSTRB, VBUF = 64 * VSTRB, TBUF = KBUF + VBUF;
constexpr int L_T = 0, L_G = 2 * TBUF, L_L = L_G + 64 * 65 * 4, L_SEL = L_L + 64 * 65 * 4, L_LIST = L_SEL + 512, L_UNI = L_LIST + 496, L_OT = L_LIST + 512, L_END = L_OT + 8 * 32 * 64 * 4;
static_assert(L_END <= 136 * 1024, "NSA LDS map");
enum { T_CMP1 = 0, T_CMP2 = 1, T_SLC = 2, T_WIN = 3 };
constexpr float LOG2E = 1.4426950408889634f;

struct Ctx { const unsigned char* ws; int b, g; };
__device__ __forceinline__ void tile_src(const Ctx& c, int type, int s, unsigned& k, unsigned& ks, unsigned& v, unsigned& vs) {
    const unsigned bg = (unsigned)c.b * 4u + (unsigned)c.g;
    if (type <= T_CMP2) { k = (unsigned)WS_CMP + ((bg * 256u + 64u * s) * 64u) * 2u; ks = 128u; v = (unsigned)WS_CMP + 2u * 4u * 256u * 64u * 2u + (bg * 64u * 256u + 64u * s) * 2u; vs = 512u; }
    else { k = ((type == T_SLC) ? (unsigned)WS_KSC : (unsigned)WS_KWC) + ((bg * T + 64u * s) * 64u) * 2u; ks = 128u;
           v = ((type == T_SLC) ? (unsigned)WS_NVS : (unsigned)WS_NVW) + ((bg * 64u + s) * 64u * 64u) * 2u; vs = 128u; }
}
__device__ __forceinline__ unsigned cvtpk(float lo, float hi) { f32x2 v = {lo, hi}; return __builtin_bit_cast(unsigned, __builtin_convertvector(v, bf16x2_t)); }
__device__ __forceinline__ bf16x8 pack8(float a0, float a1, float a2, float a3, float a4, float a5, float a6, float a7) {
    u32x4 w; w.x = cvtpk(a0, a1); w.y = cvtpk(a2, a3); w.z = cvtpk(a4, a5); w.w = cvtpk(a6, a7); return __builtin_bit_cast(bf16x8, w);
}
#define NSA_SB() __builtin_amdgcn_sched_barrier(0)
__device__ __forceinline__ float qsum4(float v) {
    v += __int_as_float(__builtin_amdgcn_mov_dpp(__float_as_int(v), 0xB1, 0xF, 0xF, true));
    v += __int_as_float(__builtin_amdgcn_mov_dpp(__float_as_int(v), 0x4E, 0xF, 0xF, true));
    return v;
}
__device__ __forceinline__ float x32_max(float v) { const auto rr = __builtin_amdgcn_permlane32_swap(__float_as_uint(v), __float_as_uint(v), false, false); return fmaxf(__uint_as_float(rr[0]), __uint_as_float(rr[1])); }
__device__ __forceinline__ float x32_sum(float v) { const auto rr = __builtin_amdgcn_permlane32_swap(__float_as_uint(v), __float_as_uint(v), false, false); return __uint_as_float(rr[0]) + __uint_as_float(rr[1]); }
__device__ __forceinline__ void block_compute(const int VAR, const int TY, const int MM, LAS unsigned char* tb, LAS unsigned char* lds, const bf16x8 (&qf)[4], f32x16 (&o)[2], float& m, float& l, float linv, float cbase, float cstep, int lim,
                                              int csb, int r32, int half, int hh, int tl_) {
    constexpr float QK = 0.125f * LOG2E;
#pragma unroll
    for (int tl = 0; tl < 2; ++tl) {
        f32x16 sv = (f32x16){};
#pragma unroll
        for (int ks = 0; ks < 4; ++ks) {
            const bf16x8 a0 = *(const LAS bf16x8*)(tb + (32 * tl + r32) * KSTRB + (ks * 16 + half * 8) * 2);
            sv = __builtin_amdgcn_mfma_f32_32x32x16_bf16(a0, qf[ks], sv, 0, 0, 0);
        }
        NSA_SB();
#pragma unroll
        for (int i = 0; i < 16; ++i) { const int off = 32 * tl + (i & 3) + 8 * (i >> 2); sv[i] = __builtin_fmaf(sv[i], QK, __builtin_fmaf(cstep, (float)off, cbase)); }
        if (MM != 0) {
#pragma unroll
            for (int i = 0; i < 16; ++i) { const int off = 32 * tl + (i & 3) + 8 * (i >> 2); const bool ok = (MM == 1) ? (off <= lim) : (off > lim); sv[i] = ok ? sv[i] : -INFINITY; }
        }
        NSA_SB();
        if (VAR == 1) {   } else if (TY == T_CMP2) {
            const float ms = (m == -INFINITY) ? 0.f : m;
#pragma unroll
            for (int i = 0; i < 16; ++i) sv[i] = __builtin_amdgcn_exp2f(sv[i] - ms) * linv;
            NSA_SB();
            LAS float* gb_ = (LAS float*)(lds + L_G) + tl_ * 65 + 16 * csb + half + 8 * tl;
#pragma unroll
            for (int q4 = 0; q4 < 4; ++q4) {
                float gs = (sv[4 * q4] + sv[4 * q4 + 1]) + (sv[4 * q4 + 2] + sv[4 * q4 + 3]), ls = sv[4 * q4 + 3];
                gs = qsum4(gs); ls = qsum4(ls);
                if (hh == 0) { gb_[2 * q4] = gs; gb_[64 * 65 + 2 * q4 + 1] = ls; }
            }
        } else {
            float bmax = sv[0];
#pragma unroll
            for (int i = 1; i < 16; ++i) bmax = fmaxf(bmax, sv[i]);
            bmax = x32_max(bmax);
            const float mn = fmaxf(m, bmax), ms = (mn == -INFINITY) ? 0.f : mn;
            const float alpha = __builtin_amdgcn_exp2f(m - ms); m = mn;
            float ps = 0.f;
#pragma unroll
            for (int i = 0; i < 16; ++i) { sv[i] = __builtin_amdgcn_exp2f(sv[i] - ms); ps += sv[i]; }
            l = l * alpha + ps;
            if (TY != T_CMP1) {
#pragma unroll
                for (int d = 0; d < 2; ++d) o[d] *= alpha;
            }
        }
        NSA_SB();
        if (TY != T_CMP1) {
            const bf16x8 pf0 = pack8(sv[0], sv[1], sv[2], sv[3], sv[4], sv[5], sv[6], sv[7]), pf1 = pack8(sv[8], sv[9], sv[10], sv[11], sv[12], sv[13], sv[14], sv[15]);
#pragma unroll
            for (int d = 0; d < 2; ++d) {
#pragma unroll
                for (int k2 = 0; k2 < 2; ++k2) { const int kk = 2 * tl + k2;
                    const u32x2 lo = *(const LAS u32x2*)(tb + KBUF + (32 * d + r32) * VSTRB + (16 * kk + 4 * half) * 2);
                    const u32x2 hi = *(const LAS u32x2*)(tb + KBUF + (32 * d + r32) * VSTRB + (16 * kk + 8 + 4 * half) * 2);
                    const bf16x8 af = __builtin_bit_cast(bf16x8, (u32x4){lo.x, lo.y, hi.x, hi.y});
                    o[d] = __builtin_amdgcn_mfma_f32_32x32x16_bf16(af, k2 ? pf1 : pf0, o[d], 0, 0, 0);
                }
            }
        }
        NSA_SB();
    }
}

__device__ __forceinline__ void unit(Frame& F, const Ctx& c, int qt, const int VAR) {
    LAS unsigned char* lds = F.lds;
    const int tid = F.tid, lane = F.lane, wv = F.wave, r32 = lane & 31, half = lane >> 5, hh = r32 & 3, tl_ = wv * 8 + (r32 >> 2);
    const int t = qt * 64 + tl_, row = c.b * T + t, head = c.g * 4 + hh, cur = qt;
    const float slope2 = exp2f(-0.5f * (float)(head + 1)) * LOG2E;
    float g0, g1, g2; { const float* gp = (const float*)(c.ws + ((unsigned)WS_GF + ((unsigned)row * 64u + 8u + c.g * 12u + hh * 3u) * 4u)); g0 = sigmoidf_(gp[0]); g1 = sigmoidf_(gp[1]); g2 = sigmoidf_(gp[2]); }
    bf16x8 qf[4];
#pragma unroll
    for (int ks = 0; ks < 4; ++ks) qf[ks] = *(const bf16x8*)(c.ws + ((unsigned)WS_P + ((unsigned)row * PW + PC_NQ + head * 64u + ks * 16u + half * 8u) * 2u));
    for (int i = tid; i < 2 * 64 * 65; i += NTHREADS) ((LAS float*)(lds + L_G))[i] = 0.f;
    if (tid < 2) ((LAS unsigned*)(lds + L_UNI))[tid] = 0u;
    f32x16 o[2];
#pragma unroll
    for (int d = 0; d < 2; ++d) o[d] = (f32x16){};
    LAS float* otl = (LAS float*)(lds + L_OT) + wv * 2048 + lane;
    LAS unsigned* list = (LAS unsigned*)(lds + L_LIST);
    float m = -INFINITY, l = 0.f, linv = 0.f;
    unsigned long long selrow = 0ull;
    const unsigned lrow = tid >> 3, lch = tid & 7;
    const int ncb = (4 * qt + 2) / 64 + 1;
    const int jlim = (t - 31) >> 4;
#pragma unroll 1
    for (int stage = 0; stage < 2; ++stage) {
        int N;
        if (stage == 0) { N = 2 * ncb; if (tid < N) { const int sb = tid < ncb ? tid : tid - ncb; list[tid] = (tid < ncb ? T_CMP1 : T_CMP2) | (sb << 2) | (1 << 9); } }
        else {
            const unsigned long long um = ((unsigned long long)((LAS unsigned*)(lds + L_UNI))[1] << 32) | ((LAS unsigned*)(lds + L_UNI))[0];
            const int nslc = __popcll(um), w0 = qt >= 8 ? qt - 8 : 0; N = nslc + (qt - w0 + 1);
            if (wv == 0) {
                if ((um >> lane) & 1ull) list[__popcll(um & ((1ull << lane) - 1ull))] = T_SLC | (lane << 2) | ((lane == qt ? 1 : 0) << 9);
                if (lane <= qt - w0) { const int s = w0 + lane; list[nslc + lane] = T_WIN | (s << 2) | ((s == qt ? 1 : (qt - s >= 8 ? 2 : 0)) << 9); }
            }
        }
        __syncthreads();
        u32x4 kr0 = {0u, 0u, 0u, 0u}, vr0 = kr0, kr1 = kr0, vr1 = kr0;
#define NSA_ISSUE(n, KR, VR) do { const unsigned de_ = (unsigned)__builtin_amdgcn_readfirstlane((int)list[n]); unsigned kb_, ks_, vb_, vs_; tile_src(c, de_ & 3, (de_ >> 2) & 127, kb_, ks_, vb_, vs_); \
            KR = *(const u32x4*)(c.ws + (kb_ + lrow * ks_ + lch * 16u)); if ((de_ & 3) != T_CMP1) VR = *(const u32x4*)(c.ws + (vb_ + lrow * vs_ + lch * 16u)); } while (0)
#define NSA_WRITE(buf, KR, VR) do { LAS unsigned char* tb_ = lds + L_T + (buf) * TBUF; *(LAS u32x4*)(tb_ + lrow * KSTRB + lch * 16) = KR; \
            *(LAS u32x2*)(tb_ + KBUF + lrow * VSTRB + lch * 16) = (u32x2){VR.x, VR.y}; *(LAS u32x2*)(tb_ + KBUF + lrow * VSTRB + lch * 16 + 8) = (u32x2){VR.z, VR.w}; } while (0)
        NSA_ISSUE(0, kr0, vr0);
        if (N > 1) NSA_ISSUE(1, kr1, vr1);
        NSA_WRITE(0, kr0, vr0);
        __syncthreads();
        int prev_ty = -1;
#pragma unroll 1
        for (int n = 0; n < (VAR == 2 ? 0 : N); ++n) {
            const int buf = n & 1;
            if (n + 2 < N && VAR != 3) { if (buf == 0) NSA_ISSUE(n + 2, kr0, vr0); else NSA_ISSUE(n + 2, kr1, vr1); }
            const unsigned de = (unsigned)__builtin_amdgcn_readfirstlane((int)list[n]); const int cty = de & 3, csb = (de >> 2) & 127, mm = de >> 9;
            if (cty != prev_ty) {
                if (cty == T_CMP2) { const float lt = x32_sum(l); linv = lt > 0.f ? 1.0f / lt : 0.f; }
                if (cty == T_WIN) {
                    if (prev_ty == T_SLC) { const float lt = x32_sum(l); const float sc = lt > 0.f ? g1 / lt : 0.f;
#pragma unroll
                        for (int d = 0; d < 2; ++d) {
#pragma unroll
                            for (int i = 0; i < 16; ++i) otl[(d * 16 + i) * 64] += o[d][i] * sc;
                            o[d] = (f32x16){}; } }
                    m = -INFINITY; l = 0.f;
                }
                prev_ty = cty;
            }
            NSA_SB();
            LAS unsigned char* tb = lds + L_T + buf * TBUF;
            float cbase, cstep; int lim;
            if (cty <= T_CMP2) { const int j0 = 64 * csb + 4 * half; cstep = 16.0f * slope2; cbase = -slope2 * ((float)(t - 16 * j0) - 15.5f); lim = jlim - j0; }
            else { const int k0 = 64 * csb + 4 * half; cstep = slope2; cbase = -slope2 * (float)(t - k0); lim = (mm == 2) ? (t - WIN - k0) : (t - k0);
                   if (cty == T_SLC && !((selrow >> csb) & 1ull)) cbase = -INFINITY; }
            block_compute(VAR, cty, mm, tb, lds, qf, o, m, l, linv, cbase, cstep, lim, csb, r32, half, hh, tl_);
            NSA_SB();
            if (n + 1 < N && VAR != 3) { if (buf == 0) NSA_WRITE(1, kr1, vr1); else NSA_WRITE(0, kr0, vr0); }
            __syncthreads();
        }
#undef NSA_ISSUE
#undef NSA_WRITE
        if (stage == 0) {
#pragma unroll
            for (int d = 0; d < 2; ++d) {
#pragma unroll
                for (int i = 0; i < 16; ++i) otl[(d * 16 + i) * 64] = o[d][i] * g0;
                o[d] = (f32x16){}; }
            m = -INFINITY; l = 0.f;
#pragma unroll 1
            for (int tk = 0; tk < 8; ++tk) {
                const int tok = wv * 8 + tk; unsigned long long msk;
                if (cur < TOPN) msk = (1ull << (cur + 1)) - 1ull;
                else {
                    const float iv = ((LAS float*)(lds + L_G))[tok * 65 + lane] + ((LAS float*)(lds + L_L))[tok * 65 + lane];
                    unsigned key = (lane == 0 || lane == cur) ? 0x7f800000u : (lane < cur ? (__float_as_uint(iv) & 0x7fffffc0u) : 0u);
                    key |= (unsigned)(63 - lane);
                    int rank = 0;
#pragma unroll
                    for (int s2 = 0; s2 < 64; ++s2) { const unsigned ok_ = (unsigned)__builtin_amdgcn_readlane((int)key, s2); rank += (ok_ > key) ? 1 : 0; }
                    msk = __ballot(rank < TOPN && lane <= cur);
                }
                if (lane == 0) { ((LAS unsigned long long*)(lds + L_SEL))[tok] = msk; atomicOr((unsigned*)(lds + L_UNI), (unsigned)msk); atomicOr((unsigned*)(lds + L_UNI) + 1, (unsigned)(msk >> 32)); }
            }
            __syncthreads();
            selrow = ((LAS unsigned long long*)(lds + L_SEL))[tl_];
        }
    }
    { const float lt = x32_sum(l); const float sc = lt > 0.f ? g2 / lt : 0.f;
#pragma unroll
      for (int d = 0; d < 2; ++d)
#pragma unroll
          for (int i = 0; i < 16; ++i) o[d][i] = otl[(d * 16 + i) * 64] + o[d][i] * sc; }
#pragma unroll
    for (int d = 0; d < 2; ++d)
#pragma unroll
        for (int q4 = 0; q4 < 4; ++q4) {
            const unsigned d0 = 32 * d + 8 * q4 + 4 * half;
            const u32x2 zw = *(const u32x2*)(c.ws + ((unsigned)WS_P + ((unsigned)row * PW + PC_NZ + head * 64u + d0) * 2u));
            const float z0 = __uint_as_float(zw.x << 16), z1 = __uint_as_float(zw.x & 0xffff0000u), z2 = __uint_as_float(zw.y << 16), z3 = __uint_as_float(zw.y & 0xffff0000u);
            u32x2 w; w.x = cvtpk(o[d][4 * q4] * siluf_(z0), o[d][4 * q4 + 1] * siluf_(z1)); w.y = cvtpk(o[d][4 * q4 + 2] * siluf_(z2), o[d][4 * q4 + 3] * siluf_(z3));
            *(u32x2*)(F.ws + ((unsigned)WS_Y + ((unsigned)row * 2048u + 1024u + head * 64u + d0) * 2u)) = w;
        }
    __syncthreads();
}
__device__ __forceinline__ void phase(Frame& F, const int VAR = 0) {
    Ctx c; c.ws = F.ws;
    for (int L = F.bid; L < 256; L += F.G)
        for (int i = 0; i < 2; ++i) { c.b = (L & 7) >> 2; c.g = L & 3; unit(F, c, i ? 63 - (L >> 3) : (L >> 3), VAR); }
}
}

__device__ __forceinline__ void p10_final(Frame& F) {
    const int gw = F.bid * NWAVES + F.wave, NGW = F.G * NWAVES;
    for (int row = gw; row < MR; row += NGW) {
        f32x4* xr = (f32x4*)(F.out + (size_t)row * DM) + F.lane; f32x4 v[8]; float ss = 0.f;
#pragma unroll
        for (int j = 0; j < 8; ++j) { v[j] = xr[64 * j]; ss += (v[j][0] * v[j][0] + v[j][1] * v[j][1]) + (v[j][2] * v[j][2] + v[j][3] * v[j][3]); }
        const float rstd = rsqrtf(wave_sum(ss) * (1.0f / DM) + EPS);
#pragma unroll
        for (int j = 0; j < 8; ++j) { const f32x4 g = *(const f32x4*)(F.in[I_FINALG] + 256 * j + 4 * F.lane); xr[64 * j] = v[j] * rstd * g; }
    }
}

#define XB_TMO      128
#define XB_XCNT(j)  (256  + 64 * (j))
#define XB_XSUB(j)  (1280 + 64 * (j))
#define XB_XGEN(j)  (2304 + 64 * (j))
#define XB_TOP      3328
#define XB_TOPGEN   3392
#define XCD_BAR_WORDS 3456
#define XB_SPIN_CAP (1u << 18)
__device__ __forceinline__ unsigned xb_ld(unsigned* p)              { return __hip_atomic_load(p, __ATOMIC_RELAXED, __HIP_MEMORY_SCOPE_AGENT); }
__device__ __forceinline__ unsigned xb_add(unsigned* p, unsigned v) { return __hip_atomic_fetch_add(p, v, __ATOMIC_RELAXED, __HIP_MEMORY_SCOPE_AGENT); }
__device__ __forceinline__ unsigned xb_xcc_id() { return (unsigned)__builtin_amdgcn_s_getreg((3 << 11) | 20) & 0xFu; }
#define XB_SPIN(cond, bar) do { unsigned _sp = 0; while (cond) { __builtin_amdgcn_s_sleep(1); \
    if ((++_sp & 255u) == 0u) { if (xb_ld(&(bar)[XB_TMO])) break; if (_sp > XB_SPIN_CAP) { atomicAdd(&(bar)[XB_TMO], 1u); break; } } } } while (0)
struct XcdBarrier { unsigned* bar; unsigned x; volatile LAS unsigned* st; };
__device__ __forceinline__ XcdBarrier xcd_barrier_post(unsigned* bar, volatile LAS unsigned* st) {
    XcdBarrier b; b.bar = bar; b.x = xb_xcc_id(); b.st = st;
    if (threadIdx.x == 0) (void)xb_add(&bar[XB_XCNT(b.x)], 1u);
    return b;
}
__device__ __forceinline__ void xcd_barrier_complete(unsigned* bar, unsigned x, unsigned& nloc, unsigned& nx) {
    const unsigned G = gridDim.x * gridDim.y * gridDim.z;
    unsigned sum, cnt, mine, sp = 0u;
    for (;;) {
        sum = 0u; cnt = 0u; mine = 0u;
#pragma unroll
        for (unsigned j = 0; j < 16; ++j) { const unsigned c = xb_ld(&bar[XB_XCNT(j)]); sum += c; cnt += (c > 0u) ? 1u : 0u; mine = (j == x) ? c : mine; }
        if (sum == G) break;
        __builtin_amdgcn_s_sleep(1);
        if ((++sp & 255u) == 0u) { if (xb_ld(&bar[XB_TMO])) break; if (sp > XB_SPIN_CAP) { atomicAdd(&bar[XB_TMO], 1u); break; } }
    }
    nloc = mine > 0u ? mine : 1u; nx = cnt > 0u ? cnt : 1u;
}
__device__ __forceinline__ void xcd_barrier(const XcdBarrier& b) {
    asm volatile("s_waitcnt vmcnt(0)" ::: "memory");
    __syncthreads();
    if (threadIdx.x == 0) {
        unsigned* bar = b.bar;
        __builtin_amdgcn_s_waitcnt(0);
        unsigned nloc = b.st[0], nx = b.st[1];
        if (nloc == 0u) { xcd_barrier_complete(bar, b.x, nloc, nx); b.st[0] = nloc; b.st[1] = nx; }
        const unsigned old = xb_add(&bar[XB_XSUB(b.x)], 1u);
        const unsigned gen = old / nloc;
        if (old + 1u == (gen + 1u) * nloc) {
            __builtin_amdgcn_fence(__ATOMIC_RELEASE, "agent");
            asm volatile("s_waitcnt vmcnt(0)" ::: "memory");
            const unsigned og = xb_add(&bar[XB_TOP], 1u);
            const unsigned tg = og / nx;
            if (og + 1u == (tg + 1u) * nx) xb_add(&bar[XB_TOPGEN], 1u);
            else XB_SPIN(xb_ld(&bar[XB_TOPGEN]) == tg, bar);
            __builtin_amdgcn_fence(__ATOMIC_ACQUIRE, "agent");
            xb_add(&bar[XB_XGEN(b.x)], 1u);
            asm volatile("s_waitcnt vmcnt(0)" ::: "memory");
        } else {
            XB_SPIN(xb_ld(&bar[XB_XGEN(b.x)]) == gen, bar);
            __builtin_amdgcn_fence(__ATOMIC_ACQUIRE, "agent");
            asm volatile("s_waitcnt vmcnt(0)" ::: "memory");
        }
    }
    __syncthreads();
}
constexpr int CW_BAR = 4096;
constexpr int MISC_OFF = 136 * 1024 + 320;

template <int K> __device__ __forceinline__ void run_phase(Frame& F) {
    unsigned char* ws = F.ws;
    if constexpr (K == 0) p0_prologue(F);
    else if constexpr (K == 1) p1_norm(F);
    else if constexpr (K == 2) {
        SchedInproj S{(const bf16_t*)(ws + WS_HB), (const bf16_t*)(ws + WS_WIN), DM, DM, DM, F.G, F.bid};
        EpiInproj E{ws};
        run_gemm(F, S, E);
    } else if constexpr (K == 3) { p3_conv(F); p3_gates(F); p3_compress(F); }
    else if constexpr (K == 4) {
        const float* aArr = (const float*)(ws + WS_GATE); const float* AArr = aArr + 8 * T;
        SchedP4 S{(const bf16_t*)(ws + WS_XC), (const bf16_t*)(ws + WS_WQKP), F.G, F.bid, 1024, 1024, 256};
        EpiP4 E{ws, (unsigned char*)F.out};
        run_gemm(F, S, E);
    } else if constexpr (K == 5) {
        const float* aArr = (const float*)(ws + WS_GATE); const float* AArr = aArr + 8 * T;
        { SchedChunk S{(const bf16_t*)(ws + WS_Q), (const bf16_t*)(ws + WS_K), F.G, F.bid, 1024, 1024, 256, 0, 0}; EpiS E{(bf16_t*)((unsigned char*)F.out + OUT_SB), (float*)(ws + WS_DENP), aArr, AArr}; run_gemm(F, S, E); }
        { SchedChunk S{(const bf16_t*)(ws + WS_VST), (const bf16_t*)(ws + WS_KT), F.G, F.bid, T, T, 256, 1, 128}; EpiUT E{(float*)((unsigned char*)F.out + OUT_UT)}; run_gemm(F, S, E); }
    } else if constexpr (K == 6) { p6_scan(F); p6_den(F); }
    else if constexpr (K == 7) {
        const float* aArr = (const float*)(ws + WS_GATE); const float* AArr = aArr + 8 * T; const float* BArr = AArr + 8 * T;
        SchedNum S{(const bf16_t*)((unsigned char*)F.out + OUT_SB), (const bf16_t*)((unsigned char*)F.out + OUT_QS), (const bf16_t*)(ws + WS_VST), (const bf16_t*)(ws + WS_CT), F.G, F.bid, 1024, T, 512, 256};
        EpiNum E{(float*)((unsigned char*)F.out + OUT_UT), (const float*)(ws + SM_DEN), AArr, BArr}; run_gemm(F, S, E);
    } else if constexpr (K == 8) p8_mout(F);
    else if constexpr (K == 9) {
#if USE_FAST_NSA
#ifdef NSA_PROBE_VAR
        nsa::phase(F, NSA_PROBE_VAR);
#endif
        nsa::phase(F);
#else
        pn_nsa_naive(F);
#endif
    } else if constexpr (K == 10) {
        SchedGrid S{(const bf16_t*)(ws + WS_Y), (const bf16_t*)(ws + WS_WOUT), DM, DM, DM, MR / 256, DM / 256, F.G, F.bid};
        EpiOut E{F.in[I_X], (const float*)(ws + SM_MOD), F.out}; run_gemm(F, S, E);
    } else p10_final(F);
}
#ifndef PROBE_LO_
#define PROBE_LO_ 0
#define PROBE_HI_ 0
#endif
constexpr int PROBE_LO = PROBE_LO_, PROBE_HI = PROBE_HI_;
constexpr int NPHASE = 12;
__global__ void __launch_bounds__(NTHREADS, 2) fwd(Args args) {
    extern __shared__ __attribute__((aligned(16))) unsigned char lds[];
    Frame F; F.lds = (LAS unsigned char*)lds; F.tid = threadIdx.x; F.lane = F.tid & 63; F.wave = __builtin_amdgcn_readfirstlane(F.tid >> 6); F.G = gridDim.x; F.bid = blockIdx.x;
#pragma unroll
    for (int i = 0; i < 22; ++i) F.in[i] = args.in[i];
    F.out = args.out; F.ws = args.ws;
    unsigned char* ws = F.ws;
    const int lo = args.ph_lo, hi = args.ph_hi;
    volatile LAS unsigned* MISC = (volatile LAS unsigned*)(F.lds + MISC_OFF);
    for (int u = F.tid; u < (LDS_BYTES - 136 * 1024) / 4; u += NTHREADS) ((LAS unsigned*)(F.lds + 136 * 1024))[u] = 0u;
    __syncthreads();
    XcdBarrier bar = xcd_barrier_post((unsigned*)(ws + WS_CTL) + CW_BAR + args.li * XCD_BAR_WORDS, MISC + 8);
#define IN(k) (lo <= (k) && (k) < hi)
#define SEAM(k) do { if (IN(k) && IN((k) + 1)) xcd_barrier(bar); } while (0)
#define RP(j) do { if constexpr (PROBE_LO <= (j) && (j) < PROBE_HI) { run_phase<(j)>(F); if ((j) + 1 < PROBE_HI) xcd_barrier(bar); } } while (0)
#define PH(k) do { if (IN(k)) run_phase<(k)>(F); \
        if constexpr ((k) + 1 == PROBE_HI && PROBE_HI > PROBE_LO) { xcd_barrier(bar); RP(0); RP(1); RP(2); RP(3); RP(4); RP(5); RP(6); RP(7); RP(8); RP(9); RP(10); RP(11); } \
        SEAM(k); } while (0)
    PH(0); PH(1); PH(2); PH(3); PH(4); PH(5); PH(6); PH(7); PH(8); PH(9); PH(10); PH(11);
#undef PH
#undef RP
#undef IN
#undef SEAM
}

extern "C" void kernel_launch(void* const* d_in, const int* in_sizes, int n_in, void* d_out, int out_size, void* d_ws, size_t ws_size, hipStream_t stream) {
    static int grid = 0;
    if (grid == 0) {
        if (n_in != 22 || in_sizes[0] != MR * DM || out_size != MR * DM || ws_size < WS_END) { fprintf(stderr, "kernel_launch: unexpected shapes (n_in %d, in0 %d, out %d, ws %zu)\n", n_in, n_in > 0 ? in_sizes[0] : -1, out_size, ws_size); grid = -1; return; }
        int dev = 0, cus = 0;
        if (hipGetDevice(&dev) != hipSuccess || hipDeviceGetAttribute(&cus, hipDeviceAttributeMultiprocessorCount, dev) != hipSuccess) { grid = -1; return; }
        if (hipFuncSetAttribute((const void*)fwd, hipFuncAttributeMaxDynamicSharedMemorySize, LDS_BYTES) != hipSuccess) { fprintf(stderr, "kernel_launch: hipFuncSetAttribute failed\n"); grid = -1; return; }
        (void)hipGetLastError();
        grid = cus;
    }
    if (grid < 0) return;
    (void)hipMemsetAsync((char*)d_ws + WS_CTL, 0, CTL_ZERO_BYTES, stream);
    Args a{};
    for (int i = 0; i < 22; ++i) a.in[i] = (const float*)d_in[i];
    a.out = (float*)d_out; a.ws = (unsigned char*)d_ws;
#ifndef N_LAUNCH_PER_PHASE
    a.ph_lo = 0; a.ph_hi = NPHASE; a.li = 0;
    hipLaunchKernelGGL(fwd, dim3(grid), dim3(NTHREADS), LDS_BYTES, stream, a);
#else
    for (int ph = 0; ph < NPHASE; ++ph) {
        a.ph_lo = ph; a.ph_hi = ph + 1; a.li = ph;
        hipLaunchKernelGGL(fwd, dim3(grid), dim3(NTHREADS), LDS_BYTES, stream, a);
    }
#endif
}
```
